# Optimizing an MI355X kernel written in HIP

```python
import jax, jax.numpy as jnp
from jax import lax
import numpy as np

D_MODEL = 1024
BATCH = 8
SEQ = 2048
DEPTH = 2

HEAD_DIM = 64
SWA_Q_HEADS = 8
SWA_KV_HEADS = 2
SWA_WINDOW = 128
MOBA_HEADS = 8
MOBA_BLOCK = 256
MOBA_TOPK = 3
MOBA_Q_CHUNK = 32
D_FF = 4 * D_MODEL
ROPE_THETA = 10000.0
NORM_EPS = 1e-6
NEG_INF = -1e30

SWA_Q_W = SWA_Q_HEADS * HEAD_DIM
SWA_KV_W = SWA_KV_HEADS * HEAD_DIM
MOBA_W = MOBA_HEADS * HEAD_DIM
IN_SPLITS = [SWA_Q_W, SWA_KV_W, SWA_KV_W, MOBA_W, MOBA_W, MOBA_W, D_MODEL, D_MODEL]
IN_W = int(sum(IN_SPLITS))
IN_OFFSETS = [int(o) for o in np.cumsum(IN_SPLITS)[:-1]]

kernel_name = "hybrid_swa_sink_moba_sqrelu_adaln"


def rms_norm(x, gain):
    xf = x.astype(jnp.float32)
    y = xf * lax.rsqrt(jnp.mean(xf * xf, axis=-1, keepdims=True) + NORM_EPS)
    return (y * gain.astype(jnp.float32)).astype(x.dtype)


def rope(x, positions):
    half = HEAD_DIM // 2
    inv_freq = ROPE_THETA ** (-jnp.arange(half, dtype=jnp.float32) / half)
    ang = positions.astype(jnp.float32)[..., None] * inv_freq
    cos = jnp.cos(ang)[:, :, None, :]
    sin = jnp.sin(ang)[:, :, None, :]
    xf = x.astype(jnp.float32)
    x1, x2 = xf[..., :half], xf[..., half:]
    out = jnp.concatenate([x1 * cos - x2 * sin, x2 * cos + x1 * sin], axis=-1)
    return out.astype(x.dtype)


def swa_attention(q, k, v, sinks):
    B, S = q.shape[:2]
    W = SWA_WINDOW
    nb = S // W
    G = SWA_Q_HEADS // SWA_KV_HEADS
    qb = q.reshape(B, nb, W, SWA_KV_HEADS, G, HEAD_DIM)

    def band(t):
        tb = t.reshape(B, nb, W, SWA_KV_HEADS, HEAD_DIM)
        prev = jnp.pad(tb[:, :-1], ((0, 0), (1, 0), (0, 0), (0, 0), (0, 0)))
        return jnp.concatenate([prev, tb], axis=2)

    kb, vb = band(k), band(v)
    s = jnp.einsum('bnqhgd,bnkhd->bnhgqk', qb, kb,
                   preferred_element_type=jnp.float32) * (HEAD_DIM ** -0.5)
    qi = jnp.arange(W)[:, None]
    kj = jnp.arange(2 * W)[None, :]
    diff = qi + W - kj
    blk = jnp.arange(nb)[:, None, None]
    valid = (diff >= 0) & (diff < W) & (blk * W - W + kj >= 0)
    s = jnp.where(valid[None, :, None, None], s, NEG_INF)
    sink = sinks.astype(jnp.float32).reshape(SWA_KV_HEADS, G)[None, None, :, :, None, None]
    sink = jnp.broadcast_to(sink, s.shape[:-1] + (1,))
    p = jax.nn.softmax(jnp.concatenate([s, sink], axis=-1), axis=-1)[..., :-1]
    o = jnp.einsum('bnhgqk,bnkhd->bnqhgd', p.astype(v.dtype), vb)
    return o.reshape(B, S, SWA_Q_W)


def _take_blocks(blocks, idx):
    return blocks[idx]


_gather_bh = jax.vmap(jax.vmap(_take_blocks))


def moba_attention(q, k, v):
    B, S = q.shape[:2]
    L = MOBA_BLOCK
    nblk = -(-S // L)
    s_pad = nblk * L
    pad = ((0, 0), (0, s_pad - S), (0, 0), (0, 0))
    kb = jnp.pad(k, pad).reshape(B, nblk, L, MOBA_HEADS, HEAD_DIM).transpose(0, 3, 1, 2, 4)
    vb = jnp.pad(v, pad).reshape(B, nblk, L, MOBA_HEADS, HEAD_DIM).transpose(0, 3, 1, 2, 4)
    k_mean = jnp.mean(kb.astype(jnp.float32), axis=3)
    qh = q.transpose(0, 2, 1, 3)
    gate = jnp.einsum('bhsd,bhnd->bhsn', qh.astype(jnp.float32), k_mean)
    qblk = jnp.arange(S) // L
    past = jnp.arange(nblk)[None, :] < qblk[:, None]
    gate = jnp.where(past[None, None], gate, NEG_INF)
    topk = min(MOBA_TOPK, nblk)
    _, sel = lax.top_k(gate, topk)
    sel_valid = sel < qblk[None, None, :, None]
    scale = HEAD_DIM ** -0.5
    QC = MOBA_Q_CHUNK
    n_chunks = S // QC

    def chunk(ci):
        start = ci * QC
        qc = lax.dynamic_slice_in_dim(qh, start, QC, axis=2)
        selc = lax.dynamic_slice_in_dim(sel, start, QC, axis=2)
        validc = lax.dynamic_slice_in_dim(sel_valid, start, QC, axis=2)
        kg = _gather_bh(kb, selc)
        vg = _gather_bh(vb, selc)
        s_sel = jnp.einsum('bhqd,bhqtld->bhqtl', qc, kg,
                           preferred_element_type=jnp.float32) * scale
        s_sel = jnp.where(validc[..., None], s_sel, NEG_INF).reshape(B, MOBA_HEADS, QC, topk * L)
        own = start // L
        k_own = lax.dynamic_index_in_dim(kb, own, axis=2, keepdims=False)
        v_own = lax.dynamic_index_in_dim(vb, own, axis=2, keepdims=False)
        s_own = jnp.einsum('bhqd,bhld->bhql', qc, k_own,
                           preferred_element_type=jnp.float32) * scale
        qpos = start + jnp.arange(QC)
        kpos = own * L + jnp.arange(L)
        s_own = jnp.where(kpos[None, :] <= qpos[:, None], s_own, NEG_INF)
        p = jax.nn.softmax(jnp.concatenate([s_sel, s_own], axis=-1), axis=-1).astype(v.dtype)
        p_sel = p[..., :topk * L].reshape(B, MOBA_HEADS, QC, topk, L)
        p_own = p[..., topk * L:]
        return (jnp.einsum('bhqtl,bhqtld->bhqd', p_sel, vg)
                + jnp.einsum('bhql,bhld->bhqd', p_own, v_own))

    out = lax.map(chunk, jnp.arange(n_chunks))
    return out.transpose(1, 0, 3, 2, 4).reshape(B, S, MOBA_W)


def adaln(h, shift, scale):
    return h * (1 + scale[:, None, :]) + shift[:, None, :]


def hybrid_layer(x, c, positions, g_mix, g_mlp, w_ada, b_ada, w_in, qn_swa, kn_swa,
                 qn_moba, kn_moba, sinks, w_o_swa, w_o_moba, w_out, w_up, w_down):
    B, S, _ = x.shape
    mod = jax.nn.silu(c) @ w_ada + b_ada
    sh1, sc1, gt1, sh2, sc2, gt2 = jnp.split(mod, 6, axis=-1)

    h = adaln(rms_norm(x, g_mix), sh1, sc1)
    proj = h @ w_in
    q_a, k_a, v_a, q_b, k_b, v_b, gate_a, gate_b = jnp.split(proj, IN_OFFSETS, axis=-1)
    q_a = rope(rms_norm(q_a.reshape(B, S, SWA_Q_HEADS, HEAD_DIM), qn_swa), positions)
    k_a = rope(rms_norm(k_a.reshape(B, S, SWA_KV_HEADS, HEAD_DIM), kn_swa), positions)
    v_a = v_a.reshape(B, S, SWA_KV_HEADS, HEAD_DIM)
    q_b = rope(rms_norm(q_b.reshape(B, S, MOBA_HEADS, HEAD_DIM), qn_moba), positions)
    k_b = rope(rms_norm(k_b.reshape(B, S, MOBA_HEADS, HEAD_DIM), kn_moba), positions)
    v_b = v_b.reshape(B, S, MOBA_HEADS, HEAD_DIM)
    y_a = swa_attention(q_a, k_a, v_a, sinks) @ w_o_swa
    y_b = moba_attention(q_b, k_b, v_b) @ w_o_moba
    mixed = jax.nn.sigmoid(gate_a) * y_a + jax.nn.sigmoid(gate_b) * y_b
    x = x + gt1[:, None, :] * (mixed @ w_out)

    h = adaln(rms_norm(x, g_mlp), sh2, sc2)
    u = jnp.square(jax.nn.relu(h @ w_up))
    x = x + gt2[:, None, :] * (u @ w_down)
    return x


def setup_inputs(seed: int = 0) -> dict:
    key = jax.random.key(seed)
    ks = jax.random.split(key, 20)
    f32 = jnp.float32

    def nrm(k, shape, scale):
        return jax.random.normal(k, shape, f32) * scale

    x = jax.random.normal(ks[0], (BATCH, SEQ, D_MODEL), f32)
    c = jax.random.normal(ks[1], (BATCH, D_MODEL), f32)
    offs = jax.random.randint(ks[2], (BATCH, 1), 0, 1024, dtype=jnp.int32)
    positions = (jnp.arange(SEQ, dtype=jnp.int32)[None, :] + offs).astype(jnp.int32)
    return {
        "x": x,
        "c": c,
        "positions": positions,
        "rms_mix": 1.0 + nrm(ks[3], (DEPTH, D_MODEL), 0.05),
        "rms_mlp": 1.0 + nrm(ks[4], (DEPTH, D_MODEL), 0.05),
        "w_ada": nrm(ks[5], (DEPTH, D_MODEL, 6 * D_MODEL), 0.5 * D_MODEL ** -0.5),
        "b_ada": nrm(ks[6], (DEPTH, 6 * D_MODEL), 0.02),
        "w_in": nrm(ks[7], (DEPTH, D_MODEL, IN_W), D_MODEL ** -0.5),
        "q_norm_swa": 1.0 + nrm(ks[8], (DEPTH, HEAD_DIM), 0.05),
        "k_norm_swa": 1.0 + nrm(ks[9], (DEPTH, HEAD_DIM), 0.05),
        "q_norm_moba": 1.0 + nrm(ks[10], (DEPTH, HEAD_DIM), 0.05),
        "k_norm_moba": 1.0 + nrm(ks[11], (DEPTH, HEAD_DIM), 0.05),
        "swa_sinks": nrm(ks[12], (DEPTH, SWA_Q_HEADS), 0.5),
        "w_o_swa": nrm(ks[13], (DEPTH, SWA_Q_W, D_MODEL), SWA_Q_W ** -0.5),
        "w_o_moba": nrm(ks[14], (DEPTH, MOBA_W, D_MODEL), MOBA_W ** -0.5),
        "w_out": nrm(ks[15], (DEPTH, D_MODEL, D_MODEL), D_MODEL ** -0.5),
        "w_up": nrm(ks[16], (DEPTH, D_MODEL, D_FF), D_MODEL ** -0.5),
        "w_down": nrm(ks[17], (DEPTH, D_FF, D_MODEL), D_FF ** -0.5),
    }


def reference(x, c, positions, rms_mix, rms_mlp, w_ada, b_ada, w_in, q_norm_swa, k_norm_swa,
              q_norm_moba, k_norm_moba, swa_sinks, w_o_swa, w_o_moba, w_out, w_up, w_down):
    for l in range(DEPTH):
        x = hybrid_layer(x, c, positions, rms_mix[l], rms_mlp[l], w_ada[l], b_ada[l], w_in[l],
                         q_norm_swa[l], k_norm_swa[l], q_norm_moba[l], k_norm_moba[l],
                         swa_sinks[l], w_o_swa[l], w_o_moba[l], w_out[l], w_up[l], w_down[l])
    return x
```

```cpp
#include <hip/hip_runtime.h>
#include <cstdio>
#include <cstdint>
#include <cstring>

constexpr int NB = 8, SEQ = 2048, M_TOK = NB * SEQ, DM = 1024, FFD = 4096, INW = 4352, NLAYER = 2, HDIM = 64;
constexpr float NORM_EPS = 1e-6f;
constexpr float LOG2E = 1.4426950408889634f;
constexpr float QSCALE = 0.125f * LOG2E;

constexpr size_t MiB = 1u << 20;
constexpr size_t WS_CTL = 0, CTL_ZERO_BYTES = 1 * MiB;
constexpr size_t WS_WIN = 1 * MiB,  WIN_BYTES = (size_t)INW * DM * 2;
constexpr size_t WS_WO = 18 * MiB,  WO_BYTES = (size_t)DM * DM * 2;
constexpr size_t WS_WOUT = 22 * MiB, WOUT_BYTES = (size_t)DM * DM * 2;
constexpr size_t WS_WUP = 26 * MiB, WUP_BYTES = (size_t)FFD * DM * 2;
constexpr size_t WS_WDN = 42 * MiB, WDN_BYTES = (size_t)DM * FFD * 2;
constexpr size_t WS_COS = 58 * MiB, WS_SIN = 60 * MiB;
constexpr size_t WS_MOD = 62 * MiB;
constexpr size_t WS_KMEAN = 62 * MiB + 512 * 1024;
constexpr size_t KMEAN_BYTES_L = (size_t)NB * 8 * 8 * 64 * 4;
constexpr size_t WS_XN = 64 * MiB;
constexpr size_t WS_QA = 96 * MiB, WS_QB = 112 * MiB, WS_KB = 128 * MiB, WS_VB = 144 * MiB, WS_KA = 160 * MiB, WS_VA = 164 * MiB;
constexpr size_t WS_MIX = 96 * MiB;
constexpr size_t WS_SA = 168 * MiB, WS_SB = 200 * MiB;
constexpr size_t WS_H = 96 * MiB;
constexpr size_t WS_END = 256 * MiB;

#define GAS __attribute__((address_space(1)))
#define LAS __attribute__((address_space(3)))
typedef unsigned short bf16;
typedef unsigned v4u __attribute__((ext_vector_type(4)));

__device__ __forceinline__ unsigned f2bf(float f) { unsigned u = __builtin_bit_cast(unsigned, f); return (u + 0x7fffu + ((u >> 16) & 1u)) >> 16; }
__device__ __forceinline__ unsigned pk2(float lo, float hi) { return f2bf(lo) | (f2bf(hi) << 16); }
__device__ __forceinline__ float bflo(unsigned w) { return __builtin_bit_cast(float, w << 16); }
__device__ __forceinline__ float bfhi(unsigned w) { return __builtin_bit_cast(float, w & 0xffff0000u); }

__host__ __device__ __forceinline__ int in_rowmap(int c) {
    const int s = c < 512 ? c : (c < 768 ? 2048 + (c - 512) : (c < 2304 ? 512 + (c - 768) : c));
    const int tile = s >> 8, t = s & 255;
    return (tile << 8) + 128 * ((t >> 5) & 1) + 32 * (t >> 6) + (t & 31);
}

namespace pg8 {
#define PG8_LAS __attribute__((address_space(3)))
typedef unsigned short bf16_t;
typedef short bf16x8 __attribute__((ext_vector_type(8)));
typedef float f32x4 __attribute__((ext_vector_type(4)));
typedef unsigned u32x4 __attribute__((ext_vector_type(4)));
constexpr int BM = 256, BK = 64, HALF = 128, HTB = HALF * BK * 2  , STAGE_BYTES = 8 * HTB, NXCD = 8, WGM = 8;

__host__ __device__ __forceinline__ int lds_byte(int r, int c) { const int st = (r >> 4) * 2 + (c >> 5), rr = r & 15, cc = c & 31, ob = rr * 64 + cc * 2; return st * 1024 + (ob ^ (((ob >> 9) & 1) << 5)); }
__host__ __device__ __forceinline__ void stage_rc(int b, int& R, int& C) { const int st = b / 1024, sb = b % 1024, swz = sb ^ (((sb >> 9) & 1) << 5); R = (st >> 1) * 16 + swz / 64; C = (st & 1) * 32 + (swz % 64) / 2; }
__host__ __device__ __forceinline__ int perm32(int rho) { const int n = rho >> 4, i = rho & 15; return 8 * (i >> 2) + 4 * n + (i & 3); }

struct Unit { int pm, pn; };
struct Gemm { const bf16_t* A; const bf16_t* Bt; int M, N, K; };

struct StaticOrder {
    int nM, nN, nwg, G, c;
    __host__ __device__ void init(int M, int N, int G_, int c_) { nM = M / BM; nN = N / BM; nwg = nM * nN; G = G_; c = c_; }
    __host__ __device__ bool next(int i, Unit& u) const {
        const long L = (long)i * G + c; if (L >= nwg) return false;
        int wgid = (int)L; { const int q = nwg / NXCD, r = nwg % NXCD, xcd = wgid % NXCD, off = wgid / NXCD; wgid = (xcd < r ? xcd * (q + 1) : r * (q + 1) + (xcd - r) * q) + off; }
        const int nig = WGM * nN, gid = wgid / nig, fm = gid * WGM, gsz = (nM - fm) < WGM ? (nM - fm) : WGM;
        u.pm = fm + ((wgid % nig) % gsz); u.pn = (wgid % nig) / gsz; return true;
    }
    __device__ __forceinline__ void a_ready(const Unit&) const {}
    __device__ __forceinline__ void done(const Unit&) const {}
};


typedef float f32x2_t __attribute__((ext_vector_type(2))); typedef __bf16 bf16x2_t __attribute__((ext_vector_type(2)));
__device__ __forceinline__ unsigned cvt_pk_bf16(float lo, float hi) { f32x2_t v = {lo, hi}; bf16x2_t b = __builtin_convertvector(v, bf16x2_t); return __builtin_bit_cast(unsigned, b); }
__device__ __forceinline__ float bf_lo(unsigned w) { return __builtin_bit_cast(float, w << 16); }
__device__ __forceinline__ float bf_hi(unsigned w) { return __builtin_bit_cast(float, w & 0xffff0000u); }
__device__ __forceinline__ float sigmoidf_(float x) { return __builtin_amdgcn_rcpf(1.0f + __expf(-x)); }

struct EpiIn {
    static constexpr bool PERM = true, AFTER_DRAIN = false, HAS_MID = false;
    bf16_t *QA, *KA, *VA, *QB, *KB, *VB, *SA, *SB;
    const float *cs, *sn;
    const float *qn_a, *kn_a, *qn_b, *kn_b;
    float* kmean;
    __device__ __forceinline__ void operator()(const f32x4 (&acc)[2][2][4][2], const Unit& u, int wr, int wc, int fr, int fq) const {
        const int pn = u.pn;
        asm volatile("" : "+v"(fr), "+v"(fq));
        const int row0 = u.pm * BM + wr * 64 + fr;
        if (pn >= 9) {
            bf16_t* dst = pn < 13 ? SA : SB;
            const unsigned off0 = (unsigned)row0 * 1024u + (unsigned)(256 * (pn - (pn < 13 ? 9 : 13)) + 64 * wc + 8 * fq);
#pragma unroll
            for (int ai = 0; ai < 2; ++ai)
#pragma unroll
                for (int m = 0; m < 4; ++m) {
#pragma unroll
                    for (int bj = 0; bj < 2; ++bj) { const f32x4 v0 = acc[ai][bj][m][0], v1 = acc[ai][bj][m][1]; u32x4 w;
                        w.x = cvt_pk_bf16(sigmoidf_(v0[0]), sigmoidf_(v0[1])); w.y = cvt_pk_bf16(sigmoidf_(v0[2]), sigmoidf_(v0[3]));
                        w.z = cvt_pk_bf16(sigmoidf_(v1[0]), sigmoidf_(v1[1])); w.w = cvt_pk_bf16(sigmoidf_(v1[2]), sigmoidf_(v1[3]));
                        *(u32x4*)(dst + (off0 + (unsigned)((ai * HALF + m * 16) * 1024 + 32 * bj))) = w; } }
            return;
        }
        const int b = u.pm >> 3, srow0 = (u.pm & 7) * BM + wr * 64 + fr;
        bf16_t* dst; int head, nh; const float* gain = nullptr; bool isq = false, iskb = false;
        if (pn < 2)      { dst = QA; head = 4 * pn + wc;       nh = 8; gain = qn_a; isq = true; }
        else if (pn < 4) { dst = QB; head = 4 * (pn - 2) + wc; nh = 8; gain = qn_b; isq = true; }
        else if (pn < 6) { dst = KB; head = 4 * (pn - 4) + wc; nh = 8; gain = kn_b; iskb = true; }
        else if (pn < 8) { dst = VB; head = 4 * (pn - 6) + wc; nh = 8; }
        else if (wc < 2) { dst = KA; head = wc;     nh = 2; gain = kn_a; }
        else             { dst = VA; head = wc - 2; nh = 2; }
        const unsigned doff0 = (unsigned)(((b * nh + head) * 2048 + srow0) * 64 + 8 * fq);
        if (gain == nullptr) {
#pragma unroll
            for (int ai = 0; ai < 2; ++ai)
#pragma unroll
                for (int m = 0; m < 4; ++m) {
#pragma unroll
                    for (int bj = 0; bj < 2; ++bj) { const f32x4 v0 = acc[ai][bj][m][0], v1 = acc[ai][bj][m][1]; u32x4 w;
                        w.x = cvt_pk_bf16(v0[0], v0[1]); w.y = cvt_pk_bf16(v0[2], v0[3]); w.z = cvt_pk_bf16(v1[0], v1[1]); w.w = cvt_pk_bf16(v1[2], v1[3]);
                        *(u32x4*)(dst + (doff0 + (unsigned)((ai * HALF + m * 16) * 64 + 32 * bj))) = w; } }
            return;
        }
        f32x4 g[2][2];
#pragma unroll
        for (int bj = 0; bj < 2; ++bj)
#pragma unroll
            for (int n = 0; n < 2; ++n) g[bj][n] = *(const f32x4*)(gain + 32 * bj + 8 * fq + 4 * n);
        const float osc = isq ? 0.18033688011112042f   : 1.0f;
        f32x4 csum[2][2];
#pragma unroll
        for (int bj = 0; bj < 2; ++bj)
#pragma unroll
            for (int n = 0; n < 2; ++n) csum[bj][n] = (f32x4){0.f, 0.f, 0.f, 0.f};
#pragma unroll
        for (int ai = 0; ai < 2; ++ai)
#pragma unroll
            for (int m = 0; m < 4; ++m) {
                const unsigned toff = (unsigned)(row0 * 32 + 8 * fq) + (unsigned)((ai * HALF + m * 16) * 32);
                f32x4 v[2][2]; float ss = 0.f;
#pragma unroll
                for (int bj = 0; bj < 2; ++bj)
#pragma unroll
                    for (int n = 0; n < 2; ++n) { v[bj][n] = acc[ai][bj][m][n]; const f32x4 x = v[bj][n]; ss += (x[0] * x[0] + x[1] * x[1]) + (x[2] * x[2] + x[3] * x[3]); }
                ss += __shfl_xor(ss, 16); ss += __shfl_xor(ss, 32);
                const float rstd = rsqrtf(ss * (1.0f / 64.0f) + 1e-6f);
                f32x4 cc[2], sv[2];
#pragma unroll
                for (int n = 0; n < 2; ++n) { cc[n] = *(const f32x4*)(cs + (toff + 4u * n)); sv[n] = *(const f32x4*)(sn + (toff + 4u * n)); }
#pragma unroll
                for (int n = 0; n < 2; ++n) {
                    const f32x4 x1 = v[0][n] * rstd * g[0][n], x2 = v[1][n] * rstd * g[1][n];
                    v[0][n] = (x1 * cc[n] - x2 * sv[n]) * osc; v[1][n] = (x2 * cc[n] + x1 * sv[n]) * osc;
                    csum[0][n] += v[0][n]; csum[1][n] += v[1][n];
                }
#pragma unroll
                for (int bj = 0; bj < 2; ++bj) { const f32x4 v0 = v[bj][0], v1 = v[bj][1]; u32x4 w;
                    w.x = cvt_pk_bf16(v0[0], v0[1]); w.y = cvt_pk_bf16(v0[2], v0[3]); w.z = cvt_pk_bf16(v1[0], v1[1]); w.w = cvt_pk_bf16(v1[2], v1[3]);
                    *(u32x4*)(dst + (doff0 + (unsigned)((ai * HALF + m * 16) * 64 + 32 * bj))) = w; }
                asm volatile("" : "+v"(csum[0][0]), "+v"(csum[0][1]), "+v"(csum[1][0]), "+v"(csum[1][1]) :: "memory");
            }
        if (iskb) {
            float* km = kmean + (unsigned)(((b * 8 + head) * 8 + (u.pm & 7)) * 64 + 8 * fq);
#pragma unroll
            for (int bj = 0; bj < 2; ++bj)
#pragma unroll
                for (int n = 0; n < 2; ++n)
#pragma unroll
                    for (int i = 0; i < 4; ++i) { float t = csum[bj][n][i];
                        t += __shfl_xor(t, 1); t += __shfl_xor(t, 2); t += __shfl_xor(t, 4); t += __shfl_xor(t, 8);
                        if (fr == 0) atomicAdd(km + 32 * bj + 4 * n + i, t * (1.0f / 256.0f)); }
        }
    }
};

struct EpiMix {
    static constexpr bool PERM = true, AFTER_DRAIN = false, HAS_MID = true;
    const bf16_t *SA, *SB; bf16_t* MIX;
    __device__ __forceinline__ void mid(f32x4 (&acc)[2][2][4][2], const Unit& u, int wr, int wc, int fr, int fq) const {
        asm volatile("" : "+v"(fr), "+v"(fq));
        const unsigned off0 = (unsigned)((u.pm * BM + wr * 64 + fr) * 1024 + u.pn * BM + wc * 32 + 8 * fq);
#pragma unroll
        for (int ai = 0; ai < 2; ++ai)
#pragma unroll
            for (int m = 0; m < 4; ++m) { const unsigned off = off0 + (unsigned)((ai * HALF + m * 16) * 1024);
#pragma unroll
                for (int bj = 0; bj < 2; ++bj) { const u32x4 a = *(const u32x4*)(SA + (off + bj * HALF)), s = *(const u32x4*)(SB + (off + bj * HALF));
                    f32x4 r0, r1;
                    r0[0] = bf_lo(a.x) * __builtin_amdgcn_rcpf(fmaxf(bf_lo(s.x), 1e-20f)); r0[1] = bf_hi(a.x) * __builtin_amdgcn_rcpf(fmaxf(bf_hi(s.x), 1e-20f));
                    r0[2] = bf_lo(a.y) * __builtin_amdgcn_rcpf(fmaxf(bf_lo(s.y), 1e-20f)); r0[3] = bf_hi(a.y) * __builtin_amdgcn_rcpf(fmaxf(bf_hi(s.y), 1e-20f));
                    r1[0] = bf_lo(a.z) * __builtin_amdgcn_rcpf(fmaxf(bf_lo(s.z), 1e-20f)); r1[1] = bf_hi(a.z) * __builtin_amdgcn_rcpf(fmaxf(bf_hi(s.z), 1e-20f));
                    r1[2] = bf_lo(a.w) * __builtin_amdgcn_rcpf(fmaxf(bf_lo(s.w), 1e-20f)); r1[3] = bf_hi(a.w) * __builtin_amdgcn_rcpf(fmaxf(bf_hi(s.w), 1e-20f));
                    acc[ai][bj][m][0] *= r0; acc[ai][bj][m][1] *= r1; }
                asm volatile("" ::: "memory"); }
    }
    __device__ __forceinline__ void operator()(const f32x4 (&acc)[2][2][4][2], const Unit& u, int wr, int wc, int fr, int fq) const {
        asm volatile("" : "+v"(fr), "+v"(fq));
        const unsigned off0 = (unsigned)((u.pm * BM + wr * 64 + fr) * 1024 + u.pn * BM + wc * 32 + 8 * fq);
#pragma unroll
        for (int ai = 0; ai < 2; ++ai)
#pragma unroll
            for (int m = 0; m < 4; ++m) { const unsigned off = off0 + (unsigned)((ai * HALF + m * 16) * 1024);
#pragma unroll
                for (int bj = 0; bj < 2; ++bj) { const u32x4 s = *(const u32x4*)(SB + (off + bj * HALF)); const f32x4 v0 = acc[ai][bj][m][0], v1 = acc[ai][bj][m][1]; u32x4 w;
                    w.x = cvt_pk_bf16(v0[0] * bf_lo(s.x), v0[1] * bf_hi(s.x)); w.y = cvt_pk_bf16(v0[2] * bf_lo(s.y), v0[3] * bf_hi(s.y));
                    w.z = cvt_pk_bf16(v1[0] * bf_lo(s.z), v1[1] * bf_hi(s.z)); w.w = cvt_pk_bf16(v1[2] * bf_lo(s.w), v1[3] * bf_hi(s.w));
                    *(u32x4*)(MIX + (off + bj * HALF)) = w; }
                asm volatile("" ::: "memory"); }
    }
};

struct EpiRes {
    static constexpr bool PERM = false, AFTER_DRAIN = false, HAS_MID = false;
    const float* xin; float* xout; const float* gate;
    __device__ __forceinline__ void operator()(const f32x4 (&acc)[2][2][4][2], const Unit& u, int wr, int wc, int fr, int fq) const {
        const int row0 = u.pm * BM + wr * 64 + fr, col0 = u.pn * BM + wc * 32 + 4 * fq, b = u.pm >> 3;
        f32x4 gv[2][2];
#pragma unroll
        for (int bj = 0; bj < 2; ++bj)
#pragma unroll
            for (int n = 0; n < 2; ++n) gv[bj][n] = *(const f32x4*)(gate + (size_t)b * 6144 + col0 + bj * HALF + n * 16);
#pragma unroll
        for (int ai = 0; ai < 2; ++ai)
#pragma unroll
            for (int m = 0; m < 4; ++m) { const size_t off = (size_t)(row0 + ai * HALF + m * 16) * 1024 + col0;
#pragma unroll
                for (int bj = 0; bj < 2; ++bj)
#pragma unroll
                    for (int n = 0; n < 2; ++n) { const f32x4 xi = *(const f32x4*)(xin + off + bj * HALF + n * 16); *(f32x4*)(xout + off + bj * HALF + n * 16) = xi + gv[bj][n] * acc[ai][bj][m][n]; } }
    }
};

struct EpiUp {
    static constexpr bool PERM = true, AFTER_DRAIN = false, HAS_MID = false;
    bf16_t* H;
    __device__ __forceinline__ void operator()(const f32x4 (&acc)[2][2][4][2], const Unit& u, int wr, int wc, int fr, int fq) const {
        const int row0 = u.pm * BM + wr * 64 + fr, col0 = u.pn * BM + wc * 32 + 8 * fq;
#pragma unroll
        for (int ai = 0; ai < 2; ++ai)
#pragma unroll
            for (int m = 0; m < 4; ++m) { bf16_t* rowp = H + (size_t)(row0 + ai * HALF + m * 16) * 4096 + col0;
#pragma unroll
                for (int bj = 0; bj < 2; ++bj) { f32x4 v0 = acc[ai][bj][m][0], v1 = acc[ai][bj][m][1];
#pragma unroll
                    for (int i = 0; i < 4; ++i) { const float a = fmaxf(v0[i], 0.f), c = fmaxf(v1[i], 0.f); v0[i] = a * a; v1[i] = c * c; }
                    u32x4 w; w.x = cvt_pk_bf16(v0[0], v0[1]); w.y = cvt_pk_bf16(v0[2], v0[3]); w.z = cvt_pk_bf16(v1[0], v1[1]); w.w = cvt_pk_bf16(v1[2], v1[3]);
                    *(u32x4*)(rowp + bj * HALF) = w; } }
    }
};

template <class Epi, class Sched, bool ALIGN_EPI = false, bool SP2 = false>
__device__ __forceinline__ void gemm_phase(PG8_LAS unsigned char* lds, const Gemm g, const Sched& S, const Epi& E) {
    const int tid = threadIdx.x, wid = __builtin_amdgcn_readfirstlane(tid >> 6), lane = tid & 63, wr = wid >> 2, wc = wid & 3, fr = lane & 15, fq = lane >> 4;
    const int K = g.K, nt = K / BK;
    unsigned voffA[2], voffB[2];
#pragma unroll
    for (int i = 0; i < 2; ++i) { int R, C; stage_rc(tid * 16 + i * 8192, R, C); const int Rb = Epi::PERM ? ((R & ~31) + perm32(R & 31)) : R;
        voffA[i] = (unsigned)(R * K + C) * 2u; voffB[i] = (unsigned)(Rb * K + C) * 2u; }
    const size_t kstep = (size_t)(BK * 2);
    const size_t hstep = (size_t)HALF * K * 2;
    const size_t tstep = 2 * hstep;
    const unsigned ldsw = (unsigned)wid * 1024u;
    const int aoff = lds_byte(wr * 64 + fr, fq * 8), boff = lds_byte(wc * 32 + fr, fq * 8);
#define PG8_SA(b, h) (((b) * 2 + (h)) * HTB)
#define PG8_SB(b, h) ((4 + (b) * 2 + (h)) * HTB)
#define PG8_STAGE(bufoff, gbase, voff) do { _Pragma("unroll") for (int _i = 0; _i < 2; ++_i) \
        __builtin_amdgcn_global_load_lds((const unsigned*)((const char*)(gbase) + (voff)[_i]), (PG8_LAS unsigned*)(lds + (bufoff) + ldsw + _i * 8192), 16, 0, 0); } while (0)
#define PG8_LDA(dst, b, h) do { _Pragma("unroll") for (int m = 0; m < 4; ++m) _Pragma("unroll") for (int k = 0; k < 2; ++k) dst[m][k] = *(const PG8_LAS bf16x8*)(lds + PG8_SA(b, h) + aoff + m * 2048 + k * 1024); } while (0)
#define PG8_LDB(dst, b, h) do { _Pragma("unroll") for (int n = 0; n < 2; ++n) _Pragma("unroll") for (int k = 0; k < 2; ++k) dst[n][k] = *(const PG8_LAS bf16x8*)(lds + PG8_SB(b, h) + boff + n * 2048 + k * 1024); } while (0)
#define PG8_MMA(ai, bj, At, Bt) do { __builtin_amdgcn_s_setprio(1); _Pragma("unroll") for (int m = 0; m < 4; ++m) _Pragma("unroll") for (int n = 0; n < 2; ++n) _Pragma("unroll") for (int k = 0; k < 2; ++k) \
        acc[ai][bj][m][n] = __builtin_amdgcn_mfma_f32_16x16x32_bf16(Bt[n][k], At[m][k], acc[ai][bj][m][n], 0, 0, 0); __builtin_amdgcn_s_setprio(0); } while (0)
#define PG8_WAIT_V(n) asm volatile("s_waitcnt vmcnt(" #n ")" ::: "memory")
#define PG8_WAIT_L(n) asm volatile("s_waitcnt lgkmcnt(" #n ")" ::: "memory")
#define PG8_BAR __builtin_amdgcn_s_barrier()
#define PG8_SCHED __builtin_amdgcn_sched_barrier(0)
    Unit cur, nxt; int ui = 0;
    if (!S.next(0, cur)) return;
    f32x4 acc[2][2][4][2];
#pragma unroll
    for (int a = 0; a < 2; ++a)
#pragma unroll
        for (int b = 0; b < 2; ++b)
#pragma unroll
            for (int m = 0; m < 4; ++m)
#pragma unroll
                for (int n = 0; n < 2; ++n) acc[a][b][m][n] = (f32x4){0.f, 0.f, 0.f, 0.f};
    bf16x8 At[4][2], B0[2][2], B1[2][2];
    const char* cA = (const char*)g.A + (size_t)cur.pm * tstep; const char* cB = (const char*)g.Bt + (size_t)cur.pn * tstep;
    S.a_ready(cur);
    if constexpr (SP2) {
        PG8_STAGE(PG8_SB(0, 0), cB, voffB); PG8_STAGE(PG8_SB(0, 1), cB + hstep, voffB); PG8_STAGE(PG8_SA(0, 0), cA, voffA); PG8_STAGE(PG8_SA(0, 1), cA + hstep, voffA);
        if (wr == 1) PG8_BAR;
        PG8_WAIT_V(2); PG8_BAR;
        PG8_STAGE(PG8_SB(1, 0), cB + kstep, voffB); PG8_STAGE(PG8_SA(1, 0), cA + kstep, voffA); PG8_STAGE(PG8_SB(1, 1), cB + hstep + kstep, voffB);
        PG8_WAIT_V(6); PG8_BAR;
    } else {
        PG8_STAGE(PG8_SB(0, 0), cB, voffB); PG8_STAGE(PG8_SA(0, 0), cA, voffA); PG8_STAGE(PG8_SB(0, 1), cB + hstep, voffB); PG8_STAGE(PG8_SA(0, 1), cA + hstep, voffA);
        if (wr == 1) PG8_BAR;
        PG8_WAIT_V(4); PG8_BAR;
        PG8_STAGE(PG8_SB(1, 0), cB + kstep, voffB); PG8_STAGE(PG8_SA(1, 0), cA + kstep, voffA); PG8_STAGE(PG8_SB(1, 1), cB + hstep + kstep, voffB);
        PG8_WAIT_V(6); PG8_BAR;
    }
    for (;;) {
        const bool has_next = S.next(ui + 1, nxt);
        const char* nA = has_next ? (const char*)g.A + (size_t)nxt.pm * tstep : cA; const char* nB = has_next ? (const char*)g.Bt + (size_t)nxt.pn * tstep : cB;
        for (int t = 0; t < nt; t += 2) {
            const bool last = (t == nt - 2);
            const char* a1 = cA + (size_t)(t + 1) * kstep;
            const char* a2 = last ? nA : cA + (size_t)(t + 2) * kstep; const char* b2 = last ? nB : cB + (size_t)(t + 2) * kstep;
            const char* a3 = a2 + kstep; const char* b3 = b2 + kstep;
            if (last && has_next) S.a_ready(nxt);
            if constexpr (SP2) {
            PG8_LDB(B0, 0, 0); PG8_LDB(B1, 0, 1); PG8_SCHED; PG8_LDA(At, 0, 0); PG8_STAGE(PG8_SA(1, 1), a1 + hstep, voffA);
            PG8_WAIT_V(8); PG8_WAIT_L(0); PG8_BAR; PG8_MMA(0, 0, At, B0); PG8_MMA(0, 1, At, B1); PG8_BAR; PG8_SCHED;
            PG8_LDA(At, 0, 1); PG8_STAGE(PG8_SB(0, 0), b2, voffB); PG8_STAGE(PG8_SB(0, 1), b2 + hstep, voffB); PG8_STAGE(PG8_SA(0, 0), a2, voffA);
            PG8_WAIT_V(8); PG8_WAIT_L(0); PG8_BAR; PG8_MMA(1, 0, At, B0); PG8_MMA(1, 1, At, B1); PG8_BAR; PG8_SCHED;
            PG8_LDB(B0, 1, 0); PG8_LDB(B1, 1, 1); PG8_SCHED; PG8_LDA(At, 1, 0); PG8_STAGE(PG8_SA(0, 1), a2 + hstep, voffA);
            PG8_WAIT_V(8); PG8_WAIT_L(0); PG8_BAR; PG8_MMA(0, 0, At, B0); PG8_MMA(0, 1, At, B1); PG8_BAR; PG8_SCHED;
            PG8_LDA(At, 1, 1); PG8_STAGE(PG8_SB(1, 0), b3, voffB); PG8_STAGE(PG8_SB(1, 1), b3 + hstep, voffB); PG8_STAGE(PG8_SA(1, 0), a3, voffA);
            PG8_WAIT_V(8); PG8_WAIT_L(0); PG8_BAR; PG8_MMA(1, 0, At, B0); PG8_MMA(1, 1, At, B1); PG8_BAR; PG8_SCHED;
            } else {
            PG8_LDB(B0, 0, 0); PG8_SCHED; PG8_LDA(At, 0, 0); PG8_STAGE(PG8_SA(1, 1), a1 + hstep, voffA);
            PG8_WAIT_L(8); PG8_BAR; PG8_WAIT_L(0); PG8_MMA(0, 0, At, B0); PG8_BAR; PG8_SCHED;
            PG8_LDB(B1, 0, 1); PG8_STAGE(PG8_SB(0, 0), b2, voffB);
            PG8_BAR; PG8_WAIT_L(0); PG8_MMA(0, 1, At, B1); PG8_BAR;
            PG8_LDA(At, 0, 1); PG8_STAGE(PG8_SA(0, 0), a2, voffA);
            PG8_BAR; PG8_WAIT_L(0); PG8_MMA(1, 0, At, B0); PG8_BAR; PG8_SCHED;
            PG8_STAGE(PG8_SB(0, 1), b2 + hstep, voffB);
            PG8_WAIT_V(6); PG8_BAR; PG8_MMA(1, 1, At, B1); PG8_BAR;
            PG8_LDB(B0, 1, 0); PG8_SCHED; PG8_LDA(At, 1, 0); PG8_STAGE(PG8_SA(0, 1), a2 + hstep, voffA);
            PG8_WAIT_L(8); PG8_BAR; PG8_WAIT_L(0); PG8_MMA(0, 0, At, B0); PG8_BAR; PG8_SCHED;
            PG8_LDB(B1, 1, 1); PG8_STAGE(PG8_SB(1, 0), b3, voffB);
            PG8_BAR; PG8_WAIT_L(0); PG8_MMA(0, 1, At, B1); PG8_BAR;
            PG8_LDA(At, 1, 1); PG8_STAGE(PG8_SA(1, 0), a3, voffA);
            PG8_BAR; PG8_WAIT_L(0); PG8_MMA(1, 0, At, B0); PG8_BAR; PG8_SCHED;
            PG8_STAGE(PG8_SB(1, 1), b3 + hstep, voffB);
            PG8_WAIT_V(6); PG8_BAR; PG8_MMA(1, 1, At, B1); PG8_BAR;
            }
            if constexpr (Epi::HAS_MID) { if (t + 2 == (nt >> 1)) E.mid(acc, cur, wr, wc, fr, fq); }
        }
        if constexpr (ALIGN_EPI) { if (wr == 0) PG8_BAR; }
        if constexpr (!Epi::AFTER_DRAIN) { E(acc, cur, wr, wc, fr, fq); S.done(cur); }
        if (!has_next) break;
#pragma unroll
        for (int a = 0; a < 2; ++a)
#pragma unroll
            for (int b = 0; b < 2; ++b)
#pragma unroll
                for (int m = 0; m < 4; ++m)
#pragma unroll
                    for (int n = 0; n < 2; ++n) acc[a][b][m][n] = (f32x4){0.f, 0.f, 0.f, 0.f};
        cur = nxt; cA = nA; cB = nB; ++ui;
        if constexpr (ALIGN_EPI) { if (wr == 1) PG8_BAR; }
    }
    PG8_WAIT_V(0);
    if constexpr (!ALIGN_EPI) { if (wr == 0) PG8_BAR; }
    PG8_BAR;
    if constexpr (Epi::AFTER_DRAIN) { E.fused(acc, cur, wr, wc, fr, fq, lds, wid, lane); S.done(cur); }
#undef PG8_SA
#undef PG8_SB
#undef PG8_STAGE
#undef PG8_LDA
#undef PG8_LDB
#undef PG8_MMA
#undef PG8_WAIT_V
#undef PG8_WAIT_L
#undef PG8_BAR
#undef PG8_SCHED
}
}

constexpr int NWAVES = 8;
#define LDS_WAIT() asm volatile("s_waitcnt lgkmcnt(0)" ::: "memory")

__device__ __forceinline__ float wave_sum(float v) {
#pragma unroll
    for (int o = 1; o < 64; o <<= 1) v += __shfl_xor(v, o);
    return v;
}

template <bool PERMIN>
__device__ __forceinline__ void transpose_item(const float* W, int K, int N, bf16* WT, int ldk, int koff, LAS float* scr, int item, int lane) {
    const int nblk = N / 32, kb = item / nblk, nb = item % nblk, k0 = 64 * kb, n0 = 32 * nb;
#pragma unroll 8
    for (int i = 0; i < 32; ++i) { const int kk = 2 * i + (lane >> 5); scr[kk * 33 + (lane & 31)] = W[(size_t)(k0 + kk) * N + n0 + (lane & 31)]; }
    LDS_WAIT(); asm volatile("" ::: "memory");
    const int c = lane & 7;
#pragma unroll
    for (int j = 0; j < 4; ++j) { const int n = (lane >> 3) + 8 * j; const LAS float* s = scr + (8 * c) * 33 + n;
        v4u o; o.x = pk2(s[0 * 33], s[1 * 33]); o.y = pk2(s[2 * 33], s[3 * 33]); o.z = pk2(s[4 * 33], s[5 * 33]); o.w = pk2(s[6 * 33], s[7 * 33]);
        const int prow = PERMIN ? in_rowmap(n0 + n) : (n0 + n);
        *(GAS v4u*)(WT + (size_t)prow * ldk + koff + k0 + 8 * c) = o; }
    LDS_WAIT(); asm volatile("" ::: "memory");
}

struct WArgs { const float *w_in, *w_o_swa, *w_o_moba, *w_out, *w_up, *w_down; unsigned char* ws; };
__global__ void __launch_bounds__(512, 2) convert_weights_k(WArgs a) {
    extern __shared__ __attribute__((aligned(16))) unsigned char lds[];
    const int tid = threadIdx.x, lane = tid & 63, wave = tid >> 6;
    LAS float* scr = (LAS float*)((LAS unsigned char*)lds + wave * 16384);
    const int gw = blockIdx.x * NWAVES + wave, NGW = gridDim.x * NWAVES;
    constexpr int I_IN = (DM / 64) * (INW / 32), I_OS = (512 / 64) * (DM / 32), I_OUT = (DM / 64) * (DM / 32), I_UP = (DM / 64) * (FFD / 32), I_DN = (FFD / 64) * (DM / 32);
    constexpr int PER_L = I_IN + 2 * I_OS + I_OUT + I_UP + I_DN;
    for (int it = gw; it < NLAYER * PER_L; it += NGW) {
        const int l = it / PER_L; int r = it % PER_L;
        unsigned char* ws = a.ws;
        if (r < I_IN) { transpose_item<true>(a.w_in + (size_t)l * DM * INW, DM, INW, (bf16*)(ws + WS_WIN + l * WIN_BYTES), DM, 0, scr, r, lane); continue; } r -= I_IN;
        if (r < I_OS) { transpose_item<false>(a.w_o_swa + (size_t)l * 512 * DM, 512, DM, (bf16*)(ws + WS_WO + l * WO_BYTES), DM, 0, scr, r, lane); continue; } r -= I_OS;
        if (r < I_OS) { transpose_item<false>(a.w_o_moba + (size_t)l * 512 * DM, 512, DM, (bf16*)(ws + WS_WO + l * WO_BYTES), DM, 512, scr, r, lane); continue; } r -= I_OS;
        if (r < I_OUT) { transpose_item<false>(a.w_out + (size_t)l * DM * DM, DM, DM, (bf16*)(ws + WS_WOUT + l * WOUT_BYTES), DM, 0, scr, r, lane); continue; } r -= I_OUT;
        if (r < I_UP) { transpose_item<false>(a.w_up + (size_t)l * DM * FFD, DM, FFD, (bf16*)(ws + WS_WUP + l * WUP_BYTES), DM, 0, scr, r, lane); continue; } r -= I_UP;
        transpose_item<false>(a.w_down + (size_t)l * FFD * DM, FFD, DM, (bf16*)(ws + WS_WDN + l * WDN_BYTES), FFD, 0, scr, r, lane);
    }
}

__global__ void __launch_bounds__(256) ada_k(const float* c, const float* w_ada, const float* b_ada, float* mod) {
    __shared__ float sc[NB * DM];
    for (int i = threadIdx.x; i < NB * DM; i += 256) { const float v = c[i]; sc[i] = v / (1.0f + __expf(-v)); }
    __syncthreads();
    const int col = blockIdx.x * 256 + threadIdx.x;
    const int l = col / 6144, j = col % 6144;
    const float* w = w_ada + (size_t)l * DM * 6144 + j;
    float a[NB];
#pragma unroll
    for (int b = 0; b < NB; ++b) a[b] = 0.f;
    for (int k = 0; k < DM; ++k) { const float wv = w[(size_t)k * 6144];
#pragma unroll
        for (int b = 0; b < NB; ++b) a[b] += sc[b * DM + k] * wv; }
    const float bias = b_ada[l * 6144 + j];
#pragma unroll
    for (int b = 0; b < NB; ++b) mod[((size_t)l * NB + b) * 6144 + j] = a[b] + bias;
}

__global__ void __launch_bounds__(256) rope_tab_k(const int* pos, float* cs, float* sn) {
    const int i = blockIdx.x * 256 + threadIdx.x;
    const int m = i >> 5, d = i & 31;
    const float inv = powf(10000.0f, -(float)d / 32.0f);
    const float ang = (float)pos[m] * inv;
    cs[i] = cosf(ang); sn[i] = sinf(ang);
}

__device__ __forceinline__ void norm_row(const float* xrow, const float* g, const float* sh, const float* sc, bf16* orow, int lane) {
    typedef float f32x4 __attribute__((ext_vector_type(4)));
    const GAS f32x4* xr = (const GAS f32x4*)xrow + lane;
    f32x4 v[4]; float s = 0.f;
#pragma unroll
    for (int j = 0; j < 4; ++j) { v[j] = xr[64 * j]; s += (v[j].x * v[j].x + v[j].y * v[j].y) + (v[j].z * v[j].z + v[j].w * v[j].w); }
    const float rstd = rsqrtf(wave_sum(s) * (1.f / DM) + NORM_EPS);
    GAS unsigned long long* o8 = (GAS unsigned long long*)orow + lane;
#pragma unroll
    for (int j = 0; j < 4; ++j) {
        const f32x4 gg = ((const GAS f32x4*)g)[lane + 64 * j], hh = ((const GAS f32x4*)sh)[lane + 64 * j], cc = ((const GAS f32x4*)sc)[lane + 64 * j];
        const f32x4 y = v[j] * rstd * gg * (cc + 1.0f) + hh;
        o8[64 * j] = (unsigned long long)pk2(y.x, y.y) | ((unsigned long long)pk2(y.z, y.w) << 32);
    }
}
__global__ void __launch_bounds__(256) norm_k(const float* x, const float* g, const float* modl, int shoff, bf16* XN) {
    const int row = blockIdx.x * 4 + (threadIdx.x >> 6), lane = threadIdx.x & 63, b = row >> 11;
    norm_row(x + (size_t)row * DM, g, modl + (size_t)b * 6144 + shoff, modl + (size_t)b * 6144 + shoff + 1024, XN + (size_t)row * DM, lane);
}

template <class Epi> __global__ void __launch_bounds__(512, 2) gemm_k(pg8::Gemm g, Epi E) {
    extern __shared__ __attribute__((aligned(16))) unsigned char lds[];
    pg8::StaticOrder S; S.init(g.M, g.N, (int)gridDim.x, (int)blockIdx.x);
    pg8::gemm_phase<Epi, pg8::StaticOrder, true, true>((LAS unsigned char*)lds, g, S, E);
}

typedef short bf16x8_t __attribute__((ext_vector_type(8)));
__device__ __forceinline__ void ld8(const bf16* p, float* o) {
    const v4u w = *(const v4u*)p;
    o[0] = bflo(w.x); o[1] = bfhi(w.x); o[2] = bflo(w.y); o[3] = bfhi(w.y); o[4] = bflo(w.z); o[5] = bfhi(w.z); o[6] = bflo(w.w); o[7] = bfhi(w.w);
}
__global__ void __launch_bounds__(256) swa_naive_k(const bf16* QA, const bf16* KA, const bf16* VA, const float* sinks, bf16* OAB) {
    const int idx = blockIdx.x * 256 + threadIdx.x;
    const int s = idx & 2047, hq = (idx >> 11) & 7, b = idx >> 14, kvh = hq >> 2;
    float q[64], o[64];
    const bf16* qp = QA + ((size_t)(b * 8 + hq) * 2048 + s) * 64;
#pragma unroll
    for (int c = 0; c < 8; ++c) ld8(qp + 8 * c, q + 8 * c);
#pragma unroll
    for (int d = 0; d < 64; ++d) o[d] = 0.f;
    float m = -1e30f, l = 0.f;
    const bf16* kbase = KA + ((size_t)(b * 2 + kvh) * 2048) * 64; const bf16* vbase = VA + ((size_t)(b * 2 + kvh) * 2048) * 64;
    const int klo = s - 127 > 0 ? s - 127 : 0;
    for (int k = klo; k <= s; ++k) {
        float sc = 0.f;
#pragma unroll
        for (int c = 0; c < 8; ++c) { float kv[8]; ld8(kbase + (size_t)k * 64 + 8 * c, kv);
#pragma unroll
            for (int j = 0; j < 8; ++j) sc += q[8 * c + j] * kv[j]; }
        const float mn = fmaxf(m, sc), al = exp2f(m - mn), p = exp2f(sc - mn);
        l = l * al + p; m = mn;
#pragma unroll
        for (int c = 0; c < 8; ++c) { float vv[8]; ld8(vbase + (size_t)k * 64 + 8 * c, vv);
#pragma unroll
            for (int j = 0; j < 8; ++j) o[8 * c + j] = o[8 * c + j] * al + p * vv[j]; }
    }
    l += exp2f(sinks[hq] * LOG2E - m);
    const float inv = 1.0f / l;
    bf16* op = OAB + (size_t)(b * 2048 + s) * 1024 + hq * 64;
#pragma unroll
    for (int c = 0; c < 8; ++c) { v4u w; w.x = pk2(o[8 * c] * inv, o[8 * c + 1] * inv); w.y = pk2(o[8 * c + 2] * inv, o[8 * c + 3] * inv); w.z = pk2(o[8 * c + 4] * inv, o[8 * c + 5] * inv); w.w = pk2(o[8 * c + 6] * inv, o[8 * c + 7] * inv);
        *(v4u*)(op + 8 * c) = w; }
}
__global__ void __launch_bounds__(256) moba_naive_k(const bf16* QB, const bf16* KB, const bf16* VB, const float* kmean, bf16* OAB) {
    const int idx = blockIdx.x * 256 + threadIdx.x;
    const int s = idx & 2047, h = (idx >> 11) & 7, b = idx >> 14, qb = s >> 8;
    float q[64], o[64];
    const bf16* qp = QB + ((size_t)(b * 8 + h) * 2048 + s) * 64;
#pragma unroll
    for (int c = 0; c < 8; ++c) ld8(qp + 8 * c, q + 8 * c);
#pragma unroll
    for (int d = 0; d < 64; ++d) o[d] = 0.f;
    float gate[8];
    const float* km = kmean + (size_t)((b * 8 + h) * 8) * 64;
#pragma unroll
    for (int n = 0; n < 8; ++n) { float gsum = 0.f;
        if (n < qb) {
#pragma unroll
            for (int d = 0; d < 64; ++d) gsum += q[d] * km[n * 64 + d]; }
        gate[n] = gsum; }
    unsigned selmask = 0u;
#pragma unroll
    for (int n = 0; n < 8; ++n) { int rank = 0;
#pragma unroll
        for (int mm = 0; mm < 8; ++mm) { if (mm != n) { const bool ahead = (gate[mm] > gate[n]) || (gate[mm] == gate[n] && mm < n); rank += (mm < qb && ahead) ? 1 : 0; } }
        if (n < qb && rank < 3) selmask |= 1u << n; }
    selmask |= 1u << qb;
    float m = -1e30f, l = 0.f;
    const bf16* kbase = KB + ((size_t)(b * 8 + h) * 2048) * 64; const bf16* vbase = VB + ((size_t)(b * 8 + h) * 2048) * 64;
    for (int n = 0; n <= qb; ++n) {
        if (!((selmask >> n) & 1u)) continue;
        const int kend = (n == qb) ? s : (n * 256 + 255);
        for (int k = n * 256; k <= kend; ++k) {
            float sc = 0.f;
#pragma unroll
            for (int c = 0; c < 8; ++c) { float kv[8]; ld8(kbase + (size_t)k * 64 + 8 * c, kv);
#pragma unroll
                for (int j = 0; j < 8; ++j) sc += q[8 * c + j] * kv[j]; }
            const float mn = fmaxf(m, sc), al = exp2f(m - mn), p = exp2f(sc - mn);
            l = l * al + p; m = mn;
#pragma unroll
            for (int c = 0; c < 8; ++c) { float vv[8]; ld8(vbase + (size_t)k * 64 + 8 * c, vv);
#pragma unroll
                for (int j = 0; j < 8; ++j) o[8 * c + j] = o[8 * c + j] * al + p * vv[j]; }
        }
    }
    const float inv = 1.0f / l;
    bf16* op = OAB + (size_t)(b * 2048 + s) * 1024 + 512 + h * 64;
#pragma unroll
    for (int c = 0; c < 8; ++c) { v4u w; w.x = pk2(o[8 * c] * inv, o[8 * c + 1] * inv); w.y = pk2(o[8 * c + 2] * inv, o[8 * c + 3] * inv); w.z = pk2(o[8 * c + 4] * inv, o[8 * c + 5] * inv); w.w = pk2(o[8 * c + 6] * inv, o[8 * c + 7] * inv);
        *(v4u*)(op + 8 * c) = w; }
}

static pg8::Gemm mkgemm(const bf16* A, const bf16* Bt, int M, int N, int K) { pg8::Gemm g; memset(&g, 0, sizeof(g)); g.A = A; g.Bt = Bt; g.M = M; g.N = N; g.K = K; return g; }
extern "C" void kernel_launch(void* const* d_in, const int* in_sizes, int n_in, void* d_out, int out_size, void* d_ws, size_t ws_size, hipStream_t stream) {
    static int ready = 0;
    constexpr int GEMM_LDS = 131072;
    if (ready == 0) {
        if (n_in != 18 || in_sizes[0] != M_TOK * DM || out_size != M_TOK * DM || ws_size < WS_END) { fprintf(stderr, "kernel_launch: unexpected shapes (n_in %d, ws %zu)\n", n_in, ws_size); ready = -1; return; }
        bool ok = true;
        ok &= hipFuncSetAttribute((const void*)convert_weights_k, hipFuncAttributeMaxDynamicSharedMemorySize, GEMM_LDS) == hipSuccess;
        ok &= hipFuncSetAttribute((const void*)gemm_k<pg8::EpiIn>, hipFuncAttributeMaxDynamicSharedMemorySize, GEMM_LDS) == hipSuccess;
        ok &= hipFuncSetAttribute((const void*)gemm_k<pg8::EpiMix>, hipFuncAttributeMaxDynamicSharedMemorySize, GEMM_LDS) == hipSuccess;
        ok &= hipFuncSetAttribute((const void*)gemm_k<pg8::EpiRes>, hipFuncAttributeMaxDynamicSharedMemorySize, GEMM_LDS) == hipSuccess;
        ok &= hipFuncSetAttribute((const void*)gemm_k<pg8::EpiUp>, hipFuncAttributeMaxDynamicSharedMemorySize, GEMM_LDS) == hipSuccess;
        if (!ok) { fprintf(stderr, "kernel_launch: hipFuncSetAttribute failed\n"); ready = -1; return; }
        ready = 1;
    }
    if (ready < 0) return;
    const float* x = (const float*)d_in[0]; const float* c = (const float*)d_in[1]; const int* pos = (const int*)d_in[2];
    const float* rms_mix = (const float*)d_in[3]; const float* rms_mlp = (const float*)d_in[4];
    const float* w_ada = (const float*)d_in[5]; const float* b_ada = (const float*)d_in[6];
    const float* qn_a = (const float*)d_in[8]; const float* kn_a = (const float*)d_in[9]; const float* qn_b = (const float*)d_in[10]; const float* kn_b = (const float*)d_in[11];
    const float* sinks = (const float*)d_in[12];
    unsigned char* ws = (unsigned char*)d_ws; float* out = (float*)d_out;
    float* cs = (float*)(ws + WS_COS); float* sn = (float*)(ws + WS_SIN); float* mod = (float*)(ws + WS_MOD); float* kmean = (float*)(ws + WS_KMEAN);
    bf16* XN = (bf16*)(ws + WS_XN); bf16* OAB = XN;
    bf16 *QA = (bf16*)(ws + WS_QA), *QB = (bf16*)(ws + WS_QB), *KB = (bf16*)(ws + WS_KB), *VB = (bf16*)(ws + WS_VB), *KA = (bf16*)(ws + WS_KA), *VA = (bf16*)(ws + WS_VA);
    bf16 *MIX = (bf16*)(ws + WS_MIX), *SA = (bf16*)(ws + WS_SA), *SB = (bf16*)(ws + WS_SB), *H = (bf16*)(ws + WS_H);

    (void)hipMemsetAsync(ws + WS_KMEAN, 0, NLAYER * KMEAN_BYTES_L, stream);
    WArgs wa{}; wa.w_in = (const float*)d_in[7]; wa.w_o_swa = (const float*)d_in[13]; wa.w_o_moba = (const float*)d_in[14]; wa.w_out = (const float*)d_in[15]; wa.w_up = (const float*)d_in[16]; wa.w_down = (const float*)d_in[17]; wa.ws = ws;
    hipLaunchKernelGGL(convert_weights_k, dim3(256), dim3(512), GEMM_LDS, stream, wa);
    hipLaunchKernelGGL(ada_k, dim3(NLAYER * 6144 / 256), dim3(256), 0, stream, c, w_ada, b_ada, mod);
    hipLaunchKernelGGL(rope_tab_k, dim3(M_TOK * 32 / 256), dim3(256), 0, stream, pos, cs, sn);

    for (int l = 0; l < NLAYER; ++l) {
        const float* xin = (l == 0) ? x : out;
        const float* modl = mod + (size_t)l * NB * 6144;
        hipLaunchKernelGGL(norm_k, dim3(M_TOK / 4), dim3(256), 0, stream, xin, rms_mix + l * DM, modl, 0, XN);
        { pg8::Gemm g = mkgemm(XN, (const bf16*)(ws + WS_WIN + l * WIN_BYTES), M_TOK, INW, DM);
          pg8::EpiIn E{}; E.QA = QA; E.KA = KA; E.VA = VA; E.QB = QB; E.KB = KB; E.VB = VB; E.SA = SA; E.SB = SB; E.cs = cs; E.sn = sn;
          E.qn_a = qn_a + l * 64; E.kn_a = kn_a + l * 64; E.qn_b = qn_b + l * 64; E.kn_b = kn_b + l * 64; E.kmean = kmean + (size_t)l * (KMEAN_BYTES_L / 4);
          hipLaunchKernelGGL(gemm_k<pg8::EpiIn>, dim3(256), dim3(512), GEMM_LDS, stream, g, E); }
        hipLaunchKernelGGL(swa_naive_k, dim3(NB * 8 * SEQ / 256), dim3(256), 0, stream, QA, KA, VA, sinks + l * 8, OAB);
        hipLaunchKernelGGL(moba_naive_k, dim3(NB * 8 * SEQ / 256), dim3(256), 0, stream, QB, KB, VB, kmean + (size_t)l * (KMEAN_BYTES_L / 4), OAB);
        { pg8::Gemm g = mkgemm(OAB, (const bf16*)(ws + WS_WO + l * WO_BYTES), M_TOK, DM, DM);
          pg8::EpiMix E{}; E.SA = SA; E.SB = SB; E.MIX = MIX;
          hipLaunchKernelGGL(gemm_k<pg8::EpiMix>, dim3(256), dim3(512), GEMM_LDS, stream, g, E); }
        { pg8::Gemm g = mkgemm(MIX, (const bf16*)(ws + WS_WOUT + l * WOUT_BYTES), M_TOK, DM, DM);
          pg8::EpiRes E{}; E.xin = xin; E.xout = out; E.gate = modl + 2048;
          hipLaunchKernelGGL(gemm_k<pg8::EpiRes>, dim3(256), dim3(512), GEMM_LDS, stream, g, E); }
        hipLaunchKernelGGL(norm_k, dim3(M_TOK / 4), dim3(256), 0, stream, (const float*)out, rms_mlp + l * DM, modl, 3072, XN);
        { pg8::Gemm g = mkgemm(XN, (const bf16*)(ws + WS_WUP + l * WUP_BYTES), M_TOK, FFD, DM);
          pg8::EpiUp E{}; E.H = H;
          hipLaunchKernelGGL(gemm_k<pg8::EpiUp>, dim3(256), dim3(512), GEMM_LDS, stream, g, E); }
        { pg8::Gemm g = mkgemm(H, (const bf16*)(ws + WS_WDN + l * WDN_BYTES), M_TOK, DM, FFD);
          pg8::EpiRes E{}; E.xin = out; E.xout = out; E.gate = modl + 5120;
          hipLaunchKernelGGL(gemm_k<pg8::EpiRes>, dim3(256), dim3(512), GEMM_LDS, stream, g, E); }
    }
}
```

```cpp
#include <hip/hip_runtime.h>
#include <cstdio>
#include <cstdint>
#include <cstring>

constexpr int NB = 8, SEQ = 2048, M_TOK = NB * SEQ, DM = 1024, FFD = 4096, INW = 4352, NLAYER = 2, HDIM = 64;
constexpr float NORM_EPS = 1e-6f;
constexpr float LOG2E = 1.4426950408889634f;
constexpr float QSCALE = 0.125f * LOG2E;

constexpr size_t MiB = 1u << 20;
constexpr size_t WS_CTL = 0, CTL_ZERO_BYTES = 1 * MiB;
constexpr size_t WS_WIN = 1 * MiB,  WIN_BYTES = (size_t)INW * DM * 2;
constexpr size_t WS_WO = 18 * MiB,  WO_BYTES = (size_t)DM * DM * 2;
constexpr size_t WS_WOUT = 22 * MiB, WOUT_BYTES = (size_t)DM * DM * 2;
constexpr size_t WS_WUP = 26 * MiB, WUP_BYTES = (size_t)FFD * DM * 2;
constexpr size_t WS_WDN = 42 * MiB, WDN_BYTES = (size_t)DM * FFD * 2;
constexpr size_t WS_COS = 58 * MiB, WS_SIN = 60 * MiB;
constexpr size_t WS_MOD = 62 * MiB;
constexpr size_t WS_KMEAN = 62 * MiB + 512 * 1024;
constexpr size_t KMEAN_BYTES_L = (size_t)NB * 8 * 8 * 64 * 4;
constexpr size_t WS_XN = 64 * MiB;
constexpr size_t WS_QA = 96 * MiB, WS_QB = 112 * MiB, WS_KB = 128 * MiB, WS_VB = 144 * MiB, WS_KA = 160 * MiB, WS_VA = 164 * MiB;
constexpr size_t WS_MIX = 96 * MiB;
constexpr size_t WS_SA = 168 * MiB, WS_SB = 200 * MiB;
constexpr size_t WS_H = 96 * MiB;
constexpr size_t WS_END = 256 * MiB;

#define GAS __attribute__((address_space(1)))
#define LAS __attribute__((address_space(3)))
typedef unsigned short bf16;
typedef unsigned v4u __attribute__((ext_vector_type(4)));

__device__ __forceinline__ unsigned f2bf(float f) { unsigned u = __builtin_bit_cast(unsigned, f); return (u + 0x7fffu + ((u >> 16) & 1u)) >> 16; }
__device__ __forceinline__ unsigned pk2(float lo, float hi) { return f2bf(lo) | (f2bf(hi) << 16); }
__device__ __forceinline__ float bflo(unsigned w) { return __builtin_bit_cast(float, w << 16); }
__device__ __forceinline__ float bfhi(unsigned w) { return __builtin_bit_cast(float, w & 0xffff0000u); }

__host__ __device__ __forceinline__ int in_rowmap(int c) {
    const int s = c < 512 ? c : (c < 768 ? 2048 + (c - 512) : (c < 2304 ? 512 + (c - 768) : c));
    const int tile = s >> 8, t = s & 255;
    return (tile << 8) + 128 * ((t >> 5) & 1) + 32 * (t >> 6) + (t & 31);
}

namespace pg8 {
#define PG8_LAS __attribute__((address_space(3)))
typedef unsigned short bf16_t;
typedef short bf16x8 __attribute__((ext_vector_type(8)));
typedef float f32x4 __attribute__((ext_vector_type(4)));
typedef unsigned u32x4 __attribute__((ext_vector_type(4)));
constexpr int BM = 256, BK = 64, HALF = 128, HTB = HALF * BK * 2  , STAGE_BYTES = 8 * HTB, NXCD = 8, WGM = 8;

__host__ __device__ __forceinline__ int lds_byte(int r, int c) { const int st = (r >> 4) * 2 + (c >> 5), rr = r & 15, cc = c & 31, ob = rr * 64 + cc * 2; return st * 1024 + (ob ^ (((ob >> 9) & 1) << 5)); }
__host__ __device__ __forceinline__ void stage_rc(int b, int& R, int& C) { const int st = b / 1024, sb = b % 1024, swz = sb ^ (((sb >> 9) & 1) << 5); R = (st >> 1) * 16 + swz / 64; C = (st & 1) * 32 + (swz % 64) / 2; }
__host__ __device__ __forceinline__ int perm32(int rho) { const int n = rho >> 4, i = rho & 15; return 8 * (i >> 2) + 4 * n + (i & 3); }

struct Unit { int pm, pn; };
struct Gemm { const bf16_t* A; const bf16_t* Bt; int M, N, K; };

struct StaticOrder {
    int nM, nN, nwg, G, c;
    __host__ __device__ void init(int M, int N, int G_, int c_) { nM = M / BM; nN = N / BM; nwg = nM * nN; G = G_; c = c_; }
    __host__ __device__ bool next(int i, Unit& u) const {
        const long L = (long)i * G + c; if (L >= nwg) return false;
        int wgid = (int)L; { const int q = nwg / NXCD, r = nwg % NXCD, xcd = wgid % NXCD, off = wgid / NXCD; wgid = (xcd < r ? xcd * (q + 1) : r * (q + 1) + (xcd - r) * q) + off; }
        const int nig = WGM * nN, gid = wgid / nig, fm = gid * WGM, gsz = (nM - fm) < WGM ? (nM - fm) : WGM;
        u.pm = fm + ((wgid % nig) % gsz); u.pn = (wgid % nig) / gsz; return true;
    }
    __device__ __forceinline__ void a_ready(const Unit&) const {}
    __device__ __forceinline__ void done(const Unit&) const {}
};


typedef float f32x2_t __attribute__((ext_vector_type(2))); typedef __bf16 bf16x2_t __attribute__((ext_vector_type(2)));
__device__ __forceinline__ unsigned cvt_pk_bf16(float lo, float hi) { f32x2_t v = {lo, hi}; bf16x2_t b = __builtin_convertvector(v, bf16x2_t); return __builtin_bit_cast(unsigned, b); }
__device__ __forceinline__ float bf_lo(unsigned w) { return __builtin_bit_cast(float, w << 16); }
__device__ __forceinline__ float bf_hi(unsigned w) { return __builtin_bit_cast(float, w & 0xffff0000u); }
__device__ __forceinline__ float sigmoidf_(float x) { return __builtin_amdgcn_rcpf(1.0f + __expf(-x)); }

struct EpiIn {
    static constexpr bool PERM = true, AFTER_DRAIN = false, HAS_MID = false;
    bf16_t *QA, *KA, *VA, *QB, *KB, *VB, *SA, *SB;
    const float *cs, *sn;
    const float *qn_a, *kn_a, *qn_b, *kn_b;
    float* kmean;
    __device__ __forceinline__ void operator()(const f32x4 (&acc)[2][2][4][2], const Unit& u, int wr, int wc, int fr, int fq) const {
        const int pn = u.pn;
        asm volatile("" : "+v"(fr), "+v"(fq));
        const int row0 = u.pm * BM + wr * 64 + fr;
        if (pn >= 9) {
            bf16_t* dst = pn < 13 ? SA : SB;
            const unsigned off0 = (unsigned)row0 * 1024u + (unsigned)(256 * (pn - (pn < 13 ? 9 : 13)) + 64 * wc + 8 * fq);
#pragma unroll
            for (int ai = 0; ai < 2; ++ai)
#pragma unroll
                for (int m = 0; m < 4; ++m) {
#pragma unroll
                    for (int bj = 0; bj < 2; ++bj) { const f32x4 v0 = acc[ai][bj][m][0], v1 = acc[ai][bj][m][1]; u32x4 w;
                        w.x = cvt_pk_bf16(sigmoidf_(v0[0]), sigmoidf_(v0[1])); w.y = cvt_pk_bf16(sigmoidf_(v0[2]), sigmoidf_(v0[3]));
                        w.z = cvt_pk_bf16(sigmoidf_(v1[0]), sigmoidf_(v1[1])); w.w = cvt_pk_bf16(sigmoidf_(v1[2]), sigmoidf_(v1[3]));
                        *(u32x4*)(dst + (off0 + (unsigned)((ai * HALF + m * 16) * 1024 + 32 * bj))) = w; } }
            return;
        }
        const int b = u.pm >> 3, srow0 = (u.pm & 7) * BM + wr * 64 + fr;
        bf16_t* dst; int head, nh; const float* gain = nullptr; bool isq = false, iskb = false;
        if (pn < 2)      { dst = QA; head = 4 * pn + wc;       nh = 8; gain = qn_a; isq = true; }
        else if (pn < 4) { dst = QB; head = 4 * (pn - 2) + wc; nh = 8; gain = qn_b; isq = true; }
        else if (pn < 6) { dst = KB; head = 4 * (pn - 4) + wc; nh = 8; gain = kn_b; iskb = true; }
        else if (pn < 8) { dst = VB; head = 4 * (pn - 6) + wc; nh = 8; }
        else if (wc < 2) { dst = KA; head = wc;     nh = 2; gain = kn_a; }
        else             { dst = VA; head = wc - 2; nh = 2; }
        const unsigned doff0 = (unsigned)(((b * nh + head) * 2048 + srow0) * 64 + 8 * fq);
        if (gain == nullptr) {
#pragma unroll
            for (int ai = 0; ai < 2; ++ai)
#pragma unroll
                for (int m = 0; m < 4; ++m) {
#pragma unroll
                    for (int bj = 0; bj < 2; ++bj) { const f32x4 v0 = acc[ai][bj][m][0], v1 = acc[ai][bj][m][1]; u32x4 w;
                        w.x = cvt_pk_bf16(v0[0], v0[1]); w.y = cvt_pk_bf16(v0[2], v0[3]); w.z = cvt_pk_bf16(v1[0], v1[1]); w.w = cvt_pk_bf16(v1[2], v1[3]);
                        *(u32x4*)(dst + (doff0 + (unsigned)((ai * HALF + m * 16) * 64 + 32 * bj))) = w; } }
            return;
        }
        f32x4 g[2][2];
#pragma unroll
        for (int bj = 0; bj < 2; ++bj)
#pragma unroll
            for (int n = 0; n < 2; ++n) g[bj][n] = *(const f32x4*)(gain + 32 * bj + 8 * fq + 4 * n);
        const float osc = isq ? 0.18033688011112042f   : 1.0f;
        f32x4 csum[2][2];
#pragma unroll
        for (int bj = 0; bj < 2; ++bj)
#pragma unroll
            for (int n = 0; n < 2; ++n) csum[bj][n] = (f32x4){0.f, 0.f, 0.f, 0.f};
#pragma unroll
        for (int ai = 0; ai < 2; ++ai)
#pragma unroll
            for (int m = 0; m < 4; ++m) {
                const unsigned toff = (unsigned)(row0 * 32 + 8 * fq) + (unsigned)((ai * HALF + m * 16) * 32);
                f32x4 v[2][2]; float ss = 0.f;
#pragma unroll
                for (int bj = 0; bj < 2; ++bj)
#pragma unroll
                    for (int n = 0; n < 2; ++n) { v[bj][n] = acc[ai][bj][m][n]; const f32x4 x = v[bj][n]; ss += (x[0] * x[0] + x[1] * x[1]) + (x[2] * x[2] + x[3] * x[3]); }
                ss += __shfl_xor(ss, 16); ss += __shfl_xor(ss, 32);
                const float rstd = rsqrtf(ss * (1.0f / 64.0f) + 1e-6f);
                f32x4 cc[2], sv[2];
#pragma unroll
                for (int n = 0; n < 2; ++n) { cc[n] = *(const f32x4*)(cs + (toff + 4u * n)); sv[n] = *(const f32x4*)(sn + (toff + 4u * n)); }
#pragma unroll
                for (int n = 0; n < 2; ++n) {
                    const f32x4 x1 = v[0][n] * rstd * g[0][n], x2 = v[1][n] * rstd * g[1][n];
                    v[0][n] = (x1 * cc[n] - x2 * sv[n]) * osc; v[1][n] = (x2 * cc[n] + x1 * sv[n]) * osc;
                    csum[0][n] += v[0][n]; csum[1][n] += v[1][n];
                }
#pragma unroll
                for (int bj = 0; bj < 2; ++bj) { const f32x4 v0 = v[bj][0], v1 = v[bj][1]; u32x4 w;
                    w.x = cvt_pk_bf16(v0[0], v0[1]); w.y = cvt_pk_bf16(v0[2], v0[3]); w.z = cvt_pk_bf16(v1[0], v1[1]); w.w = cvt_pk_bf16(v1[2], v1[3]);
                    *(u32x4*)(dst + (doff0 + (unsigned)((ai * HALF + m * 16) * 64 + 32 * bj))) = w; }
                asm volatile("" : "+v"(csum[0][0]), "+v"(csum[0][1]), "+v"(csum[1][0]), "+v"(csum[1][1]) :: "memory");
            }
        if (iskb) {
            float* km = kmean + (unsigned)(((b * 8 + head) * 8 + (u.pm & 7)) * 64 + 8 * fq);
#pragma unroll
            for (int bj = 0; bj < 2; ++bj)
#pragma unroll
                for (int n = 0; n < 2; ++n)
#pragma unroll
                    for (int i = 0; i < 4; ++i) { float t = csum[bj][n][i];
                        t += __shfl_xor(t, 1); t += __shfl_xor(t, 2); t += __shfl_xor(t, 4); t += __shfl_xor(t, 8);
                        if (fr == 0) atomicAdd(km + 32 * bj + 4 * n + i, t * (1.0f / 256.0f)); }
        }
    }
};

struct EpiMix {
    static constexpr bool PERM = true, AFTER_DRAIN = false, HAS_MID = true;
    const bf16_t *SA, *SB; bf16_t* MIX;
    __device__ __forceinline__ void mid(f32x4 (&acc)[2][2][4][2], const Unit& u, int wr, int wc, int fr, int fq) const {
        asm volatile("" : "+v"(fr), "+v"(fq));
        const unsigned off0 = (unsigned)((u.pm * BM + wr * 64 + fr) * 1024 + u.pn * BM + wc * 32 + 8 * fq);
#pragma unroll
        for (int ai = 0; ai < 2; ++ai)
#pragma unroll
            for (int m = 0; m < 4; ++m) { const unsigned off = off0 + (unsigned)((ai * HALF + m * 16) * 1024);
#pragma unroll
                for (int bj = 0; bj < 2; ++bj) { const u32x4 a = *(const u32x4*)(SA + (off + bj * HALF)), s = *(const u32x4*)(SB + (off + bj * HALF));
                    f32x4 r0, r1;
                    r0[0] = bf_lo(a.x) * __builtin_amdgcn_rcpf(fmaxf(bf_lo(s.x), 1e-20f)); r0[1] = bf_hi(a.x) * __builtin_amdgcn_rcpf(fmaxf(bf_hi(s.x), 1e-20f));
                    r0[2] = bf_lo(a.y) * __builtin_amdgcn_rcpf(fmaxf(bf_lo(s.y), 1e-20f)); r0[3] = bf_hi(a.y) * __builtin_amdgcn_rcpf(fmaxf(bf_hi(s.y), 1e-20f));
                    r1[0] = bf_lo(a.z) * __builtin_amdgcn_rcpf(fmaxf(bf_lo(s.z), 1e-20f)); r1[1] = bf_hi(a.z) * __builtin_amdgcn_rcpf(fmaxf(bf_hi(s.z), 1e-20f));
                    r1[2] = bf_lo(a.w) * __builtin_amdgcn_rcpf(fmaxf(bf_lo(s.w), 1e-20f)); r1[3] = bf_hi(a.w) * __builtin_amdgcn_rcpf(fmaxf(bf_hi(s.w), 1e-20f));
                    acc[ai][bj][m][0] *= r0; acc[ai][bj][m][1] *= r1; }
                asm volatile("" ::: "memory"); }
    }
    __device__ __forceinline__ void operator()(const f32x4 (&acc)[2][2][4][2], const Unit& u, int wr, int wc, int fr, int fq) const {
        asm volatile("" : "+v"(fr), "+v"(fq));
        const unsigned off0 = (unsigned)((u.pm * BM + wr * 64 + fr) * 1024 + u.pn * BM + wc * 32 + 8 * fq);
#pragma unroll
        for (int ai = 0; ai < 2; ++ai)
#pragma unroll
            for (int m = 0; m < 4; ++m) { const unsigned off = off0 + (unsigned)((ai * HALF + m * 16) * 1024);
#pragma unroll
                for (int bj = 0; bj < 2; ++bj) { const u32x4 s = *(const u32x4*)(SB + (off + bj * HALF)); const f32x4 v0 = acc[ai][bj][m][0], v1 = acc[ai][bj][m][1]; u32x4 w;
                    w.x = cvt_pk_bf16(v0[0] * bf_lo(s.x), v0[1] * bf_hi(s.x)); w.y = cvt_pk_bf16(v0[2] * bf_lo(s.y), v0[3] * bf_hi(s.y));
                    w.z = cvt_pk_bf16(v1[0] * bf_lo(s.z), v1[1] * bf_hi(s.z)); w.w = cvt_pk_bf16(v1[2] * bf_lo(s.w), v1[3] * bf_hi(s.w));
                    *(u32x4*)(MIX + (off + bj * HALF)) = w; }
                asm volatile("" ::: "memory"); }
    }
};

struct EpiRes {
    static constexpr bool PERM = false, AFTER_DRAIN = false, HAS_MID = false;
    const float* xin; float* xout; const float* gate;
    __device__ __forceinline__ void operator()(const f32x4 (&acc)[2][2][4][2], const Unit& u, int wr, int wc, int fr, int fq) const {
        const int row0 = u.pm * BM + wr * 64 + fr, col0 = u.pn * BM + wc * 32 + 4 * fq, b = u.pm >> 3;
        f32x4 gv[2][2];
#pragma unroll
        for (int bj = 0; bj < 2; ++bj)
#pragma unroll
            for (int n = 0; n < 2; ++n) gv[bj][n] = *(const f32x4*)(gate + (size_t)b * 6144 + col0 + bj * HALF + n * 16);
#pragma unroll
        for (int ai = 0; ai < 2; ++ai)
#pragma unroll
            for (int m = 0; m < 4; ++m) { const size_t off = (size_t)(row0 + ai * HALF + m * 16) * 1024 + col0;
#pragma unroll
                for (int bj = 0; bj < 2; ++bj)
#pragma unroll
                    for (int n = 0; n < 2; ++n) { const f32x4 xi = *(const f32x4*)(xin + off + bj * HALF + n * 16); *(f32x4*)(xout + off + bj * HALF + n * 16) = xi + gv[bj][n] * acc[ai][bj][m][n]; } }
    }
};

struct EpiUp {
    static constexpr bool PERM = true, AFTER_DRAIN = false, HAS_MID = false;
    bf16_t* H;
    __device__ __forceinline__ void operator()(const f32x4 (&acc)[2][2][4][2], const Unit& u, int wr, int wc, int fr, int fq) const {
        const int row0 = u.pm * BM + wr * 64 + fr, col0 = u.pn * BM + wc * 32 + 8 * fq;
#pragma unroll
        for (int ai = 0; ai < 2; ++ai)
#pragma unroll
            for (int m = 0; m < 4; ++m) { bf16_t* rowp = H + (size_t)(row0 + ai * HALF + m * 16) * 4096 + col0;
#pragma unroll
                for (int bj = 0; bj < 2; ++bj) { f32x4 v0 = acc[ai][bj][m][0], v1 = acc[ai][bj][m][1];
#pragma unroll
                    for (int i = 0; i < 4; ++i) { const float a = fmaxf(v0[i], 0.f), c = fmaxf(v1[i], 0.f); v0[i] = a * a; v1[i] = c * c; }
                    u32x4 w; w.x = cvt_pk_bf16(v0[0], v0[1]); w.y = cvt_pk_bf16(v0[2], v0[3]); w.z = cvt_pk_bf16(v1[0], v1[1]); w.w = cvt_pk_bf16(v1[2], v1[3]);
                    *(u32x4*)(rowp + bj * HALF) = w; } }
    }
};

template <class Epi, class Sched, bool ALIGN_EPI = false, bool SP2 = false>
__device__ __forceinline__ void gemm_phase(PG8_LAS unsigned char* lds, const Gemm g, const Sched& S, const Epi& E) {
    int tid_ = threadIdx.x; asm volatile("" : "+v"(tid_));
    const int tid = tid_, wid = __builtin_amdgcn_readfirstlane(tid >> 6), lane = tid & 63, wr = wid >> 2, wc = wid & 3, fr = lane & 15, fq = lane >> 4;
    const int K = g.K, nt = K / BK;
    unsigned voffA[2], voffB[2];
#pragma unroll
    for (int i = 0; i < 2; ++i) { int R, C; stage_rc(tid * 16 + i * 8192, R, C); const int Rb = Epi::PERM ? ((R & ~31) + perm32(R & 31)) : R;
        voffA[i] = (unsigned)(R * K + C) * 2u; voffB[i] = (unsigned)(Rb * K + C) * 2u; }
    const size_t kstep = (size_t)(BK * 2);
    const size_t hstep = (size_t)HALF * K * 2;
    const size_t tstep = 2 * hstep;
    const unsigned ldsw = (unsigned)wid * 1024u;
    const int aoff = lds_byte(wr * 64 + fr, fq * 8), boff = lds_byte(wc * 32 + fr, fq * 8);
#define PG8_SA(b, h) (((b) * 2 + (h)) * HTB)
#define PG8_SB(b, h) ((4 + (b) * 2 + (h)) * HTB)
#define PG8_STAGE(bufoff, gbase, voff) do { _Pragma("unroll") for (int _i = 0; _i < 2; ++_i) \
        __builtin_amdgcn_global_load_lds((const unsigned*)((const char*)(gbase) + (voff)[_i]), (PG8_LAS unsigned*)(lds + (bufoff) + ldsw + _i * 8192), 16, 0, 0); } while (0)
#define PG8_LDA(dst, b, h) do { _Pragma("unroll") for (int m = 0; m < 4; ++m) _Pragma("unroll") for (int k = 0; k < 2; ++k) dst[m][k] = *(const PG8_LAS bf16x8*)(lds + PG8_SA(b, h) + aoff + m * 2048 + k * 1024); } while (0)
#define PG8_LDB(dst, b, h) do { _Pragma("unroll") for (int n = 0; n < 2; ++n) _Pragma("unroll") for (int k = 0; k < 2; ++k) dst[n][k] = *(const PG8_LAS bf16x8*)(lds + PG8_SB(b, h) + boff + n * 2048 + k * 1024); } while (0)
#define PG8_MMA(ai, bj, At, Bt) do { __builtin_amdgcn_s_setprio(1); _Pragma("unroll") for (int m = 0; m < 4; ++m) _Pragma("unroll") for (int n = 0; n < 2; ++n) _Pragma("unroll") for (int k = 0; k < 2; ++k) \
        acc[ai][bj][m][n] = __builtin_amdgcn_mfma_f32_16x16x32_bf16(Bt[n][k], At[m][k], acc[ai][bj][m][n], 0, 0, 0); __builtin_amdgcn_s_setprio(0); } while (0)
#define PG8_WAIT_V(n) asm volatile("s_waitcnt vmcnt(" #n ")" ::: "memory")
#define PG8_WAIT_L(n) asm volatile("s_waitcnt lgkmcnt(" #n ")" ::: "memory")
#define PG8_BAR __builtin_amdgcn_s_barrier()
#define PG8_SCHED __builtin_amdgcn_sched_barrier(0)
    Unit cur, nxt; int ui = 0;
    if (!S.next(0, cur)) return;
    f32x4 acc[2][2][4][2];
#pragma unroll
    for (int a = 0; a < 2; ++a)
#pragma unroll
        for (int b = 0; b < 2; ++b)
#pragma unroll
            for (int m = 0; m < 4; ++m)
#pragma unroll
                for (int n = 0; n < 2; ++n) acc[a][b][m][n] = (f32x4){0.f, 0.f, 0.f, 0.f};
    bf16x8 At[4][2], B0[2][2], B1[2][2];
    const char* cA = (const char*)g.A + (size_t)cur.pm * tstep; const char* cB = (const char*)g.Bt + (size_t)cur.pn * tstep;
    S.a_ready(cur);
    if constexpr (SP2) {
        PG8_STAGE(PG8_SB(0, 0), cB, voffB); PG8_STAGE(PG8_SB(0, 1), cB + hstep, voffB); PG8_STAGE(PG8_SA(0, 0), cA, voffA); PG8_STAGE(PG8_SA(0, 1), cA + hstep, voffA);
        if (wr == 1) PG8_BAR;
        PG8_WAIT_V(2); PG8_BAR;
        PG8_STAGE(PG8_SB(1, 0), cB + kstep, voffB); PG8_STAGE(PG8_SA(1, 0), cA + kstep, voffA); PG8_STAGE(PG8_SB(1, 1), cB + hstep + kstep, voffB);
        PG8_WAIT_V(6); PG8_BAR;
    } else {
        PG8_STAGE(PG8_SB(0, 0), cB, voffB); PG8_STAGE(PG8_SA(0, 0), cA, voffA); PG8_STAGE(PG8_SB(0, 1), cB + hstep, voffB); PG8_STAGE(PG8_SA(0, 1), cA + hstep, voffA);
        if (wr == 1) PG8_BAR;
        PG8_WAIT_V(4); PG8_BAR;
        PG8_STAGE(PG8_SB(1, 0), cB + kstep, voffB); PG8_STAGE(PG8_SA(1, 0), cA + kstep, voffA); PG8_STAGE(PG8_SB(1, 1), cB + hstep + kstep, voffB);
        PG8_WAIT_V(6); PG8_BAR;
    }
    for (;;) {
        const bool has_next = S.next(ui + 1, nxt);
        const char* nA = has_next ? (const char*)g.A + (size_t)nxt.pm * tstep : cA; const char* nB = has_next ? (const char*)g.Bt + (size_t)nxt.pn * tstep : cB;
        for (int t = 0; t < nt; t += 2) {
            const bool last = (t == nt - 2);
            const char* a1 = cA + (size_t)(t + 1) * kstep;
            const char* a2 = last ? nA : cA + (size_t)(t + 2) * kstep; const char* b2 = last ? nB : cB + (size_t)(t + 2) * kstep;
            const char* a3 = a2 + kstep; const char* b3 = b2 + kstep;
            if (last && has_next) S.a_ready(nxt);
            if constexpr (SP2) {
            PG8_LDB(B0, 0, 0); PG8_LDB(B1, 0, 1); PG8_SCHED; PG8_LDA(At, 0, 0); PG8_STAGE(PG8_SA(1, 1), a1 + hstep, voffA);
            PG8_WAIT_V(8); PG8_WAIT_L(0); PG8_BAR; PG8_MMA(0, 0, At, B0); PG8_MMA(0, 1, At, B1); PG8_BAR; PG8_SCHED;
            PG8_LDA(At, 0, 1); PG8_STAGE(PG8_SB(0, 0), b2, voffB); PG8_STAGE(PG8_SB(0, 1), b2 + hstep, voffB); PG8_STAGE(PG8_SA(0, 0), a2, voffA);
            PG8_WAIT_V(8); PG8_WAIT_L(0); PG8_BAR; PG8_MMA(1, 0, At, B0); PG8_MMA(1, 1, At, B1); PG8_BAR; PG8_SCHED;
            PG8_LDB(B0, 1, 0); PG8_LDB(B1, 1, 1); PG8_SCHED; PG8_LDA(At, 1, 0); PG8_STAGE(PG8_SA(0, 1), a2 + hstep, voffA);
            PG8_WAIT_V(8); PG8_WAIT_L(0); PG8_BAR; PG8_MMA(0, 0, At, B0); PG8_MMA(0, 1, At, B1); PG8_BAR; PG8_SCHED;
            PG8_LDA(At, 1, 1); PG8_STAGE(PG8_SB(1, 0), b3, voffB); PG8_STAGE(PG8_SB(1, 1), b3 + hstep, voffB); PG8_STAGE(PG8_SA(1, 0), a3, voffA);
            PG8_WAIT_V(8); PG8_WAIT_L(0); PG8_BAR; PG8_MMA(1, 0, At, B0); PG8_MMA(1, 1, At, B1); PG8_BAR; PG8_SCHED;
            } else {
            PG8_LDB(B0, 0, 0); PG8_SCHED; PG8_LDA(At, 0, 0); PG8_STAGE(PG8_SA(1, 1), a1 + hstep, voffA);
            PG8_WAIT_L(8); PG8_BAR; PG8_WAIT_L(0); PG8_MMA(0, 0, At, B0); PG8_BAR; PG8_SCHED;
            PG8_LDB(B1, 0, 1); PG8_STAGE(PG8_SB(0, 0), b2, voffB);
            PG8_BAR; PG8_WAIT_L(0); PG8_MMA(0, 1, At, B1); PG8_BAR;
            PG8_LDA(At, 0, 1); PG8_STAGE(PG8_SA(0, 0), a2, voffA);
            PG8_BAR; PG8_WAIT_L(0); PG8_MMA(1, 0, At, B0); PG8_BAR; PG8_SCHED;
            PG8_STAGE(PG8_SB(0, 1), b2 + hstep, voffB);
            PG8_WAIT_V(6); PG8_BAR; PG8_MMA(1, 1, At, B1); PG8_BAR;
            PG8_LDB(B0, 1, 0); PG8_SCHED; PG8_LDA(At, 1, 0); PG8_STAGE(PG8_SA(0, 1), a2 + hstep, voffA);
            PG8_WAIT_L(8); PG8_BAR; PG8_WAIT_L(0); PG8_MMA(0, 0, At, B0); PG8_BAR; PG8_SCHED;
            PG8_LDB(B1, 1, 1); PG8_STAGE(PG8_SB(1, 0), b3, voffB);
            PG8_BAR; PG8_WAIT_L(0); PG8_MMA(0, 1, At, B1); PG8_BAR;
            PG8_LDA(At, 1, 1); PG8_STAGE(PG8_SA(1, 0), a3, voffA);
            PG8_BAR; PG8_WAIT_L(0); PG8_MMA(1, 0, At, B0); PG8_BAR; PG8_SCHED;
            PG8_STAGE(PG8_SB(1, 1), b3 + hstep, voffB);
            PG8_WAIT_V(6); PG8_BAR; PG8_MMA(1, 1, At, B1); PG8_BAR;
            }
            if constexpr (Epi::HAS_MID) { if (t + 2 == (nt >> 1)) E.mid(acc, cur, wr, wc, fr, fq); }
        }
        if constexpr (ALIGN_EPI) { if (wr == 0) PG8_BAR; }
        if constexpr (!Epi::AFTER_DRAIN) { E(acc, cur, wr, wc, fr, fq); S.done(cur); }
        if (!has_next) break;
#pragma unroll
        for (int a = 0; a < 2; ++a)
#pragma unroll
            for (int b = 0; b < 2; ++b)
#pragma unroll
                for (int m = 0; m < 4; ++m)
#pragma unroll
                    for (int n = 0; n < 2; ++n) acc[a][b][m][n] = (f32x4){0.f, 0.f, 0.f, 0.f};
        cur = nxt; cA = nA; cB = nB; ++ui;
        if constexpr (ALIGN_EPI) { if (wr == 1) PG8_BAR; }
    }
    PG8_WAIT_V(0);
    if constexpr (!ALIGN_EPI) { if (wr == 0) PG8_BAR; }
    PG8_BAR;
    if constexpr (Epi::AFTER_DRAIN) { E.fused(acc, cur, wr, wc, fr, fq, lds, wid, lane); S.done(cur); }
#undef PG8_SA
#undef PG8_SB
#undef PG8_STAGE
#undef PG8_LDA
#undef PG8_LDB
#undef PG8_MMA
#undef PG8_WAIT_V
#undef PG8_WAIT_L
#undef PG8_BAR
#undef PG8_SCHED
}
}

constexpr int NWAVES = 8;
constexpr int RING_OFF = 0, RING_BYTES = 131072;
constexpr int LDSCTL_OFF = RING_BYTES, MISC_OFF = LDSCTL_OFF + 320;
constexpr int LDS_BYTES = 147456;
constexpr int CW_BAR = 4096;
constexpr size_t CTL_BYTES = 65536;
constexpr size_t WS_ADAP = 232 * MiB;
typedef GAS unsigned gu32;
#define RLX_AGENT __ATOMIC_RELAXED, __HIP_MEMORY_SCOPE_AGENT
#define LDS_WAIT() asm volatile("s_waitcnt lgkmcnt(0)" ::: "memory")
#define VM_WAIT() asm volatile("s_waitcnt vmcnt(0)" ::: "memory")

#define XB_TMO      128
#define XB_XCNT(j)  (256  + 64 * (j))
#define XB_XSUB(j)  (1280 + 64 * (j))
#define XB_XGEN(j)  (2304 + 64 * (j))
#define XB_TOP      3328
#define XB_TOPGEN   3392
#define XCD_BAR_WORDS 3456
#define XB_SPIN_CAP (1u << 18)

__device__ __forceinline__ unsigned xb_ld(unsigned* p)              { return __hip_atomic_load(p, __ATOMIC_RELAXED, __HIP_MEMORY_SCOPE_AGENT); }
__device__ __forceinline__ unsigned xb_add(unsigned* p, unsigned v) { return __hip_atomic_fetch_add(p, v, __ATOMIC_RELAXED, __HIP_MEMORY_SCOPE_AGENT); }
__device__ __forceinline__ unsigned xb_xcc_id() { return (unsigned)__builtin_amdgcn_s_getreg((3 << 11) | 20) & 0xFu; }
#define XB_SPIN(cond, bar) do { unsigned _sp = 0; while (cond) { __builtin_amdgcn_s_sleep(1); \
    if ((++_sp & 255u) == 0u) { if (xb_ld(&(bar)[XB_TMO])) break; if (_sp > XB_SPIN_CAP) { atomicAdd(&(bar)[XB_TMO], 1u); break; } } } } while (0)

struct XcdBarrier {
    unsigned* bar; unsigned x;
    volatile LAS unsigned* st;
};

__device__ __forceinline__ XcdBarrier xcd_barrier_post(unsigned* bar, volatile LAS unsigned* st) {
    XcdBarrier b; b.bar = bar; b.x = (unsigned)__builtin_amdgcn_readfirstlane((int)xb_xcc_id()); b.st = st;
    if (threadIdx.x == 0) (void)xb_add(&bar[XB_XCNT(b.x)], 1u);
    return b;
}
__device__ __forceinline__ void xcd_barrier_complete(unsigned* bar, unsigned x, unsigned& nloc, unsigned& nx) {
    const unsigned G = gridDim.x * gridDim.y * gridDim.z;
    unsigned sum, cnt, mine, sp = 0u;
    for (;;) {
        sum = 0u; cnt = 0u; mine = 0u;
#pragma unroll
        for (unsigned j = 0; j < 16; ++j) { const unsigned c = xb_ld(&bar[XB_XCNT(j)]); sum += c; cnt += (c > 0u) ? 1u : 0u; mine = (j == x) ? c : mine; }
        if (sum == G) break;
        __builtin_amdgcn_s_sleep(1);
        if ((++sp & 255u) == 0u) { if (xb_ld(&bar[XB_TMO])) break; if (sp > XB_SPIN_CAP) { atomicAdd(&bar[XB_TMO], 1u); break; } }
    }
    nloc = mine > 0u ? mine : 1u; nx = cnt > 0u ? cnt : 1u;
}

__device__ __forceinline__ void xcd_barrier(const XcdBarrier& b) {
    asm volatile("s_waitcnt vmcnt(0)" ::: "memory");
    __syncthreads();
    if (threadIdx.x == 0) {
        unsigned* bar = b.bar;
        __builtin_amdgcn_s_waitcnt(0);
        unsigned nloc = b.st[0], nx = b.st[1];
        if (nloc == 0u) { xcd_barrier_complete(bar, b.x, nloc, nx); b.st[0] = nloc; b.st[1] = nx; }
        const unsigned old = xb_add(&bar[XB_XSUB(b.x)], 1u);
        const unsigned gen = old / nloc;
        if (old + 1u == (gen + 1u) * nloc) {
            __builtin_amdgcn_fence(__ATOMIC_RELEASE, "agent");
            asm volatile("s_waitcnt vmcnt(0)" ::: "memory");
            const unsigned og = xb_add(&bar[XB_TOP], 1u);
            const unsigned tg = og / nx;
            if (og + 1u == (tg + 1u) * nx) xb_add(&bar[XB_TOPGEN], 1u);
            else XB_SPIN(xb_ld(&bar[XB_TOPGEN]) == tg, bar);
            __builtin_amdgcn_fence(__ATOMIC_ACQUIRE, "agent");
            xb_add(&bar[XB_XGEN(b.x)], 1u);
            asm volatile("s_waitcnt vmcnt(0)" ::: "memory");
        } else {
            XB_SPIN(xb_ld(&bar[XB_XGEN(b.x)]) == gen, bar);
            __builtin_amdgcn_fence(__ATOMIC_ACQUIRE, "agent");
            asm volatile("s_waitcnt vmcnt(0)" ::: "memory");
        }
    }
    __syncthreads();
}

__device__ __forceinline__ float wave_sum(float v) {
#pragma unroll
    for (int o = 1; o < 64; o <<= 1) v += __shfl_xor(v, o);
    return v;
}

template <bool PERMIN>
__device__ __forceinline__ void transpose_item(const float* W, int K, int N, bf16* WT, int ldk, int koff, LAS float* scr, int item, int lane) {
    const int nblk = N / 32, kb = item / nblk, nb = item % nblk, k0 = 64 * kb, n0 = 32 * nb;
#pragma unroll 8
    for (int i = 0; i < 32; ++i) { const int kk = 2 * i + (lane >> 5); scr[kk * 33 + (lane & 31)] = W[(size_t)(k0 + kk) * N + n0 + (lane & 31)]; }
    LDS_WAIT(); asm volatile("" ::: "memory");
    const int c = lane & 7;
#pragma unroll
    for (int j = 0; j < 4; ++j) { const int n = (lane >> 3) + 8 * j; const LAS float* s = scr + (8 * c) * 33 + n;
        v4u o; o.x = pk2(s[0 * 33], s[1 * 33]); o.y = pk2(s[2 * 33], s[3 * 33]); o.z = pk2(s[4 * 33], s[5 * 33]); o.w = pk2(s[6 * 33], s[7 * 33]);
        const int prow = PERMIN ? in_rowmap(n0 + n) : (n0 + n);
        *(GAS v4u*)(WT + (size_t)prow * ldk + koff + k0 + 8 * c) = o; }
    LDS_WAIT(); asm volatile("" ::: "memory");
}

__device__ __forceinline__ void norm_row(const float* xrow, const float* g, const float* sh, const float* sc, bf16* orow, int lane) {
    typedef float f32x4 __attribute__((ext_vector_type(4)));
    const GAS f32x4* xr = (const GAS f32x4*)xrow + lane;
    f32x4 v[4]; float s = 0.f;
#pragma unroll
    for (int j = 0; j < 4; ++j) { v[j] = xr[64 * j]; s += (v[j].x * v[j].x + v[j].y * v[j].y) + (v[j].z * v[j].z + v[j].w * v[j].w); }
    const float rstd = rsqrtf(wave_sum(s) * (1.f / DM) + NORM_EPS);
    GAS unsigned long long* o8 = (GAS unsigned long long*)orow + lane;
#pragma unroll
    for (int j = 0; j < 4; ++j) {
        const f32x4 gg = ((const GAS f32x4*)g)[lane + 64 * j], hh = ((const GAS f32x4*)sh)[lane + 64 * j], cc = ((const GAS f32x4*)sc)[lane + 64 * j];
        const f32x4 y = v[j] * rstd * gg * (cc + 1.0f) + hh;
        o8[64 * j] = (unsigned long long)pk2(y.x, y.y) | ((unsigned long long)pk2(y.z, y.w) << 32);
    }
}

__device__ __forceinline__ void ld8(const bf16* p, float* o) {
    const v4u w = *(const v4u*)p;
    o[0] = bflo(w.x); o[1] = bfhi(w.x); o[2] = bflo(w.y); o[3] = bfhi(w.y); o[4] = bflo(w.z); o[5] = bfhi(w.z); o[6] = bflo(w.w); o[7] = bfhi(w.w);
}
__device__ __forceinline__ void swa_naive_item(int idx, const bf16* QA, const bf16* KA, const bf16* VA, const float* sinks, bf16* OAB) {
    const int s = idx & 2047, hq = (idx >> 11) & 7, b = idx >> 14, kvh = hq >> 2;
    float q[64], o[64];
    const bf16* qp = QA + ((size_t)(b * 8 + hq) * 2048 + s) * 64;
#pragma unroll
    for (int c = 0; c < 8; ++c) ld8(qp + 8 * c, q + 8 * c);
#pragma unroll
    for (int d = 0; d < 64; ++d) o[d] = 0.f;
    float m = -1e30f, l = 0.f;
    const bf16* kbase = KA + ((size_t)(b * 2 + kvh) * 2048) * 64; const bf16* vbase = VA + ((size_t)(b * 2 + kvh) * 2048) * 64;
    const int klo = s - 127 > 0 ? s - 127 : 0;
    for (int k = klo; k <= s; ++k) {
        float sc = 0.f;
#pragma unroll
        for (int c = 0; c < 8; ++c) { float kv[8]; ld8(kbase + (size_t)k * 64 + 8 * c, kv);
#pragma unroll
            for (int j = 0; j < 8; ++j) sc += q[8 * c + j] * kv[j]; }
        const float mn = fmaxf(m, sc), al = exp2f(m - mn), p = exp2f(sc - mn);
        l = l * al + p; m = mn;
#pragma unroll
        for (int c = 0; c < 8; ++c) { float vv[8]; ld8(vbase + (size_t)k * 64 + 8 * c, vv);
#pragma unroll
            for (int j = 0; j < 8; ++j) o[8 * c + j] = o[8 * c + j] * al + p * vv[j]; }
    }
    l += exp2f(sinks[hq] * LOG2E - m);
    const float inv = 1.0f / l;
    bf16* op = OAB + (size_t)(b * 2048 + s) * 1024 + hq * 64;
#pragma unroll
    for (int c = 0; c < 8; ++c) { v4u w; w.x = pk2(o[8 * c] * inv, o[8 * c + 1] * inv); w.y = pk2(o[8 * c + 2] * inv, o[8 * c + 3] * inv); w.z = pk2(o[8 * c + 4] * inv, o[8 * c + 5] * inv); w.w = pk2(o[8 * c + 6] * inv, o[8 * c + 7] * inv);
        *(v4u*)(op + 8 * c) = w; }
}
__device__ __forceinline__ void moba_naive_item(int idx, const bf16* QB, const bf16* KB, const bf16* VB, const float* kmean, bf16* OAB) {
    const int s = idx & 2047, h = (idx >> 11) & 7, b = idx >> 14, qb = s >> 8;
    float q[64], o[64];
    const bf16* qp = QB + ((size_t)(b * 8 + h) * 2048 + s) * 64;
#pragma unroll
    for (int c = 0; c < 8; ++c) ld8(qp + 8 * c, q + 8 * c);
#pragma unroll
    for (int d = 0; d < 64; ++d) o[d] = 0.f;
    float gate[8];
    const float* km = kmean + (size_t)((b * 8 + h) * 8) * 64;
#pragma unroll
    for (int n = 0; n < 8; ++n) { float gsum = 0.f;
        if (n < qb) {
#pragma unroll
            for (int d = 0; d < 64; ++d) gsum += q[d] * km[n * 64 + d]; }
        gate[n] = gsum; }
    unsigned selmask = 0u;
#pragma unroll
    for (int n = 0; n < 8; ++n) { int rank = 0;
#pragma unroll
        for (int mm = 0; mm < 8; ++mm) { if (mm != n) { const bool ahead = (gate[mm] > gate[n]) || (gate[mm] == gate[n] && mm < n); rank += (mm < qb && ahead) ? 1 : 0; } }
        if (n < qb && rank < 3) selmask |= 1u << n; }
    selmask |= 1u << qb;
    float m = -1e30f, l = 0.f;
    const bf16* kbase = KB + ((size_t)(b * 8 + h) * 2048) * 64; const bf16* vbase = VB + ((size_t)(b * 8 + h) * 2048) * 64;
    for (int n = 0; n <= qb; ++n) {
        if (!((selmask >> n) & 1u)) continue;
        const int kend = (n == qb) ? s : (n * 256 + 255);
        for (int k = n * 256; k <= kend; ++k) {
            float sc = 0.f;
#pragma unroll
            for (int c = 0; c < 8; ++c) { float kv[8]; ld8(kbase + (size_t)k * 64 + 8 * c, kv);
#pragma unroll
                for (int j = 0; j < 8; ++j) sc += q[8 * c + j] * kv[j]; }
            const float mn = fmaxf(m, sc), al = exp2f(m - mn), p = exp2f(sc - mn);
            l = l * al + p; m = mn;
#pragma unroll
            for (int c = 0; c < 8; ++c) { float vv[8]; ld8(vbase + (size_t)k * 64 + 8 * c, vv);
#pragma unroll
                for (int j = 0; j < 8; ++j) o[8 * c + j] = o[8 * c + j] * al + p * vv[j]; }
        }
    }
    const float inv = 1.0f / l;
    bf16* op = OAB + (size_t)(b * 2048 + s) * 1024 + 512 + h * 64;
#pragma unroll
    for (int c = 0; c < 8; ++c) { v4u w; w.x = pk2(o[8 * c] * inv, o[8 * c + 1] * inv); w.y = pk2(o[8 * c + 2] * inv, o[8 * c + 3] * inv); w.z = pk2(o[8 * c + 4] * inv, o[8 * c + 5] * inv); w.w = pk2(o[8 * c + 6] * inv, o[8 * c + 7] * inv);
        *(v4u*)(op + 8 * c) = w; }
}

struct MArgs { const void* in[18]; float* out; unsigned char* ws; };
__global__ void __launch_bounds__(NWAVES * 64, 2) mega_fwd(MArgs a) {
    extern __shared__ __attribute__((aligned(16))) unsigned char lds_raw[];
    LAS unsigned char* lds = (LAS unsigned char*)lds_raw;
    volatile LAS unsigned* MISC = (volatile LAS unsigned*)(lds + MISC_OFF);
    const int G = gridDim.x, bx = blockIdx.x, vcu = (G % 8 == 0) ? (bx % 8) * (G / 8) + bx / 8 : bx;
    const int NGW = G * NWAVES, NGT = G * NWAVES * 64;
#define FRESH_IDS() int tid_ = threadIdx.x; asm volatile("" : "+v"(tid_)); const int tid = tid_, lane = tid & 63, wave = __builtin_amdgcn_readfirstlane(tid >> 6), gw = vcu * NWAVES + wave, gt = vcu * (NWAVES * 64) + tid; (void)lane; (void)gw; (void)gt; (void)wave
    unsigned char* ws = a.ws; float* out = a.out;
    const float* x = (const float*)a.in[0]; const float* cvec = (const float*)a.in[1]; const int* pos = (const int*)a.in[2];
    const float* rms_mix = (const float*)a.in[3]; const float* rms_mlp = (const float*)a.in[4];
    const float* w_ada = (const float*)a.in[5]; const float* b_ada = (const float*)a.in[6];
    const float* qn_a = (const float*)a.in[8]; const float* kn_a = (const float*)a.in[9]; const float* qn_b = (const float*)a.in[10]; const float* kn_b = (const float*)a.in[11];
    const float* sinks = (const float*)a.in[12];
    float* cs = (float*)(ws + WS_COS); float* sn = (float*)(ws + WS_SIN); float* mod = (float*)(ws + WS_MOD); float* kmean = (float*)(ws + WS_KMEAN); float* adap = (float*)(ws + WS_ADAP);
    bf16* XN = (bf16*)(ws + WS_XN); bf16* OAB = XN;
    bf16 *QA = (bf16*)(ws + WS_QA), *QB = (bf16*)(ws + WS_QB), *KB = (bf16*)(ws + WS_KB), *VB = (bf16*)(ws + WS_VB), *KA = (bf16*)(ws + WS_KA), *VA = (bf16*)(ws + WS_VA);
    bf16 *MIX = (bf16*)(ws + WS_MIX), *SA = (bf16*)(ws + WS_SA), *SB = (bf16*)(ws + WS_SB), *H = (bf16*)(ws + WS_H);

    for (int u = threadIdx.x; u < (LDS_BYTES - LDSCTL_OFF) / 4; u += NWAVES * 64) ((LAS unsigned*)(lds + LDSCTL_OFF))[u] = 0u;
    __syncthreads();
    XcdBarrier bar = xcd_barrier_post((unsigned*)(ws + WS_CTL) + CW_BAR, MISC + 8);
#define GRID_BAR() do { XcdBarrier b_ = bar; asm volatile("" : "+s"(b_.bar), "+s"(b_.x)); xcd_barrier(b_); } while (0)

    {
        FRESH_IDS();
        LAS float* silu = (LAS float*)(lds + 98304);
        for (int i = tid; i < NB * DM; i += NWAVES * 64) { const float v = cvec[i]; silu[i] = v / (1.0f + __expf(-v)); }
        __syncthreads();
        for (int it = gw; it < NLAYER * 96 * 8; it += NGW) {
            const int kc = it & 7, cc = (it >> 3) % 96, l = it / (8 * 96), j = cc * 64 + lane;
            const float* w = w_ada + ((size_t)l * DM + kc * 128) * 6144 + j;
            float acc[NB];
#pragma unroll
            for (int b = 0; b < NB; ++b) acc[b] = 0.f;
#pragma unroll 4
            for (int k = 0; k < 128; ++k) { const float wv = w[(size_t)k * 6144];
#pragma unroll
                for (int b = 0; b < NB; ++b) acc[b] += silu[b * DM + kc * 128 + k] * wv; }
#pragma unroll
            for (int b = 0; b < NB; ++b) adap[(((size_t)kc * NLAYER + l) * NB + b) * 6144 + j] = acc[b];
        }
        LAS float* scr = (LAS float*)(lds + wave * 8704);
        const float* w_in = (const float*)a.in[7]; const float* w_o_swa = (const float*)a.in[13]; const float* w_o_moba = (const float*)a.in[14];
        const float* w_out = (const float*)a.in[15]; const float* w_up = (const float*)a.in[16]; const float* w_down = (const float*)a.in[17];
        constexpr int I_IN = (DM / 64) * (INW / 32), I_OS = (512 / 64) * (DM / 32), I_OUT = (DM / 64) * (DM / 32), I_UP = (DM / 64) * (FFD / 32), I_DN = (FFD / 64) * (DM / 32);
        constexpr int PER_L = I_IN + 2 * I_OS + I_OUT + I_UP + I_DN;
        for (int it = gw; it < NLAYER * PER_L; it += NGW) {
            const int l = it / PER_L; int r = it % PER_L;
            if (r < I_IN) { transpose_item<true>(w_in + (size_t)l * DM * INW, DM, INW, (bf16*)(ws + WS_WIN + l * WIN_BYTES), DM, 0, scr, r, lane); continue; } r -= I_IN;
            if (r < I_OS) { transpose_item<false>(w_o_swa + (size_t)l * 512 * DM, 512, DM, (bf16*)(ws + WS_WO + l * WO_BYTES), DM, 0, scr, r, lane); continue; } r -= I_OS;
            if (r < I_OS) { transpose_item<false>(w_o_moba + (size_t)l * 512 * DM, 512, DM, (bf16*)(ws + WS_WO + l * WO_BYTES), DM, 512, scr, r, lane); continue; } r -= I_OS;
            if (r < I_OUT) { transpose_item<false>(w_out + (size_t)l * DM * DM, DM, DM, (bf16*)(ws + WS_WOUT + l * WOUT_BYTES), DM, 0, scr, r, lane); continue; } r -= I_OUT;
            if (r < I_UP) { transpose_item<false>(w_up + (size_t)l * DM * FFD, DM, FFD, (bf16*)(ws + WS_WUP + l * WUP_BYTES), DM, 0, scr, r, lane); continue; } r -= I_UP;
            transpose_item<false>(w_down + (size_t)l * FFD * DM, FFD, DM, (bf16*)(ws + WS_WDN + l * WDN_BYTES), FFD, 0, scr, r, lane);
        }
        for (int i = gt; i < M_TOK * 32; i += NGT) { const int m = i >> 5, d = i & 31; const float inv = powf(10000.0f, -(float)d / 32.0f); const float ang = (float)pos[m] * inv; cs[i] = cosf(ang); sn[i] = sinf(ang); }
        for (int i = gt; i < (int)(NLAYER * KMEAN_BYTES_L / 4); i += NGT) kmean[i] = 0.f;
    }
    GRID_BAR();
    { FRESH_IDS();
      for (int i = gt; i < NLAYER * NB * 6144; i += NGT) { const int j = i % 6144, l = i / (NB * 6144); float s = b_ada[l * 6144 + j];
#pragma unroll
        for (int kc = 0; kc < 8; ++kc) s += adap[(size_t)kc * (NLAYER * NB * 6144) + i];
        mod[i] = s; } }
    GRID_BAR();

#pragma nounroll
    for (int l = 0; l < NLAYER; ++l) {
        const float* xin = (l == 0) ? x : out;
        const float* modl = mod + (size_t)l * NB * 6144;
        float* kml = kmean + (size_t)l * (KMEAN_BYTES_L / 4);
        { FRESH_IDS();
        for (int m = gw; m < M_TOK; m += NGW) { const int b = m >> 11; norm_row(xin + (size_t)m * DM, rms_mix + l * DM, modl + (size_t)b * 6144, modl + (size_t)b * 6144 + 1024, XN + (size_t)m * DM, lane); } }
        GRID_BAR();
        { pg8::Gemm g{XN, (const bf16*)(ws + WS_WIN + l * WIN_BYTES), M_TOK, INW, DM}; pg8::StaticOrder S; S.init(M_TOK, INW, G, bx);
          pg8::EpiIn E; E.QA = QA; E.KA = KA; E.VA = VA; E.QB = QB; E.KB = KB; E.VB = VB; E.SA = SA; E.SB = SB; E.cs = cs; E.sn = sn;
          E.qn_a = qn_a + l * 64; E.kn_a = kn_a + l * 64; E.qn_b = qn_b + l * 64; E.kn_b = kn_b + l * 64; E.kmean = kml;
          pg8::gemm_phase<pg8::EpiIn, pg8::StaticOrder, true, true>(lds + RING_OFF, g, S, E); }
        GRID_BAR();
        { FRESH_IDS();
        for (int i = gt; i < NB * 8 * SEQ; i += NGT) swa_naive_item(i, QA, KA, VA, sinks + l * 8, OAB); }
        { FRESH_IDS();
        for (int i = gt; i < NB * 8 * SEQ; i += NGT) moba_naive_item(i, QB, KB, VB, kml, OAB); }
        GRID_BAR();
        { pg8::Gemm g{OAB, (const bf16*)(ws + WS_WO + l * WO_BYTES), M_TOK, DM, DM}; pg8::StaticOrder S; S.init(M_TOK, DM, G, bx);
          pg8::EpiMix E; E.SA = SA; E.SB = SB; E.MIX = MIX;
          pg8::gemm_phase<pg8::EpiMix, pg8::StaticOrder, true, true>(lds + RING_OFF, g, S, E); }
        GRID_BAR();
        { pg8::Gemm g{MIX, (const bf16*)(ws + WS_WOUT + l * WOUT_BYTES), M_TOK, DM, DM}; pg8::StaticOrder S; S.init(M_TOK, DM, G, bx);
          pg8::EpiRes E; E.xin = xin; E.xout = out; E.gate = modl + 2048;
          pg8::gemm_phase<pg8::EpiRes, pg8::StaticOrder, true, true>(lds + RING_OFF, g, S, E); }
        GRID_BAR();
        { FRESH_IDS();
        for (int m = gw; m < M_TOK; m += NGW) { const int b = m >> 11; norm_row(out + (size_t)m * DM, rms_mlp + l * DM, modl + (size_t)b * 6144 + 3072, modl + (size_t)b * 6144 + 4096, XN + (size_t)m * DM, lane); } }
        GRID_BAR();
        { pg8::Gemm g{XN, (const bf16*)(ws + WS_WUP + l * WUP_BYTES), M_TOK, FFD, DM}; pg8::StaticOrder S; S.init(M_TOK, FFD, G, bx);
          pg8::EpiUp E; E.H = H;
          pg8::gemm_phase<pg8::EpiUp, pg8::StaticOrder, true, true>(lds + RING_OFF, g, S, E); }
        GRID_BAR();
        { pg8::Gemm g{H, (const bf16*)(ws + WS_WDN + l * WDN_BYTES), M_TOK, DM, FFD}; pg8::StaticOrder S; S.init(M_TOK, DM, G, bx);
          pg8::EpiRes E; E.xin = out; E.xout = out; E.gate = modl + 5120;
          pg8::gemm_phase<pg8::EpiRes, pg8::StaticOrder, true, true>(lds + RING_OFF, g, S, E); }
        if (l + 1 < NLAYER) GRID_BAR();
    }
#undef GRID_BAR
}

extern "C" void kernel_launch(void* const* d_in, const int* in_sizes, int n_in, void* d_out, int out_size, void* d_ws, size_t ws_size, hipStream_t stream) {
    static int grid = 0;
    if (grid == 0) {
        if (n_in != 18 || in_sizes[0] != M_TOK * DM || out_size != M_TOK * DM || ws_size < WS_END) { fprintf(stderr, "kernel_launch: unexpected shapes (n_in %d, ws %zu)\n", n_in, ws_size); grid = -1; return; }
        int dev = 0, cus = 0, per_cu = 0;
        if (hipGetDevice(&dev) != hipSuccess || hipDeviceGetAttribute(&cus, hipDeviceAttributeMultiprocessorCount, dev) != hipSuccess) { grid = -1; return; }
        if (hipFuncSetAttribute((const void*)mega_fwd, hipFuncAttributeMaxDynamicSharedMemorySize, LDS_BYTES) != hipSuccess) { fprintf(stderr, "kernel_launch: hipFuncSetAttribute failed\n"); grid = -1; return; }
        if (hipOccupancyMaxActiveBlocksPerMultiprocessor(&per_cu, (const void*)mega_fwd, NWAVES * 64, LDS_BYTES) != hipSuccess || per_cu < 1)
            fprintf(stderr, "kernel_launch: note: occupancy query reports %d workgroups per CU\n", per_cu);
        (void)hipGetLastError();
        grid = cus;
    }
    if (grid < 0) return;
    (void)hipMemsetAsync((char*)d_ws + WS_CTL, 0, CTL_BYTES, stream);
    MArgs a{};
    for (int i = 0; i < 18; ++i) a.in[i] = d_in[i];
    a.out = (float*)d_out; a.ws = (unsigned char*)d_ws;
    hipLaunchKernelGGL(mega_fwd, dim3(grid), dim3(NWAVES * 64), LDS_BYTES, stream, a);
}
```

```cpp
#include <hip/hip_runtime.h>
#include <cstdio>
#include <cstdint>
#include <cstring>

constexpr int NB = 8, SEQ = 2048, M_TOK = NB * SEQ, DM = 1024, FFD = 4096, INW = 4352, NLAYER = 2, HDIM = 64;
constexpr float NORM_EPS = 1e-6f;
constexpr float LOG2E = 1.4426950408889634f;
constexpr float QSCALE = 0.125f * LOG2E;

constexpr size_t MiB = 1u << 20;
constexpr size_t WS_CTL = 0, CTL_ZERO_BYTES = 1 * MiB;
constexpr size_t WS_WIN = 1 * MiB,  WIN_BYTES = (size_t)INW * DM * 2;
constexpr size_t WS_WO = 18 * MiB,  WO_BYTES = (size_t)DM * DM * 2;
constexpr size_t WS_WOUT = 22 * MiB, WOUT_BYTES = (size_t)DM * DM * 2;
constexpr size_t WS_WUP = 26 * MiB, WUP_BYTES = (size_t)FFD * DM * 2;
constexpr size_t WS_WDN = 42 * MiB, WDN_BYTES = (size_t)DM * FFD * 2;
constexpr size_t WS_COS = 58 * MiB, WS_SIN = 60 * MiB;
constexpr size_t WS_MOD = 62 * MiB;
constexpr size_t WS_KMEAN = 62 * MiB + 512 * 1024;
constexpr size_t KMEAN_BYTES_L = (size_t)NB * 8 * 8 * 64 * 4;
constexpr size_t WS_XN = 64 * MiB;
constexpr size_t WS_QA = 96 * MiB, WS_QB = 112 * MiB, WS_KB = 128 * MiB, WS_VB = 144 * MiB, WS_KA = 160 * MiB, WS_VA = 164 * MiB;
constexpr size_t WS_MIX = 96 * MiB;
constexpr size_t WS_SA = 168 * MiB, WS_SB = 200 * MiB;
constexpr size_t WS_H = 96 * MiB;
constexpr size_t WS_END = 256 * MiB;

#define GAS __attribute__((address_space(1)))
#define LAS __attribute__((address_space(3)))
typedef unsigned short bf16;
typedef unsigned v4u __attribute__((ext_vector_type(4)));

__device__ __forceinline__ unsigned f2bf(float f) { unsigned u = __builtin_bit_cast(unsigned, f); return (u + 0x7fffu + ((u >> 16) & 1u)) >> 16; }
__device__ __forceinline__ unsigned pk2(float lo, float hi) { return f2bf(lo) | (f2bf(hi) << 16); }
__device__ __forceinline__ float bflo(unsigned w) { return __builtin_bit_cast(float, w << 16); }
__device__ __forceinline__ float bfhi(unsigned w) { return __builtin_bit_cast(float, w & 0xffff0000u); }

__host__ __device__ __forceinline__ int in_rowmap(int c) {
    const int s = c < 512 ? c : (c < 768 ? 2048 + (c - 512) : (c < 2304 ? 512 + (c - 768) : c));
    const int tile = s >> 8, t = s & 255;
    return (tile << 8) + 128 * ((t >> 5) & 1) + 32 * (t >> 6) + (t & 31);
}

namespace pg8 {
#define PG8_LAS __attribute__((address_space(3)))
typedef unsigned short bf16_t;
typedef short bf16x8 __attribute__((ext_vector_type(8)));
typedef float f32x4 __attribute__((ext_vector_type(4)));
typedef unsigned u32x4 __attribute__((ext_vector_type(4)));
constexpr int BM = 256, BK = 64, HALF = 128, HTB = HALF * BK * 2  , STAGE_BYTES = 8 * HTB, NXCD = 8, WGM = 8;

__host__ __device__ __forceinline__ int lds_byte(int r, int c) { const int st = (r >> 4) * 2 + (c >> 5), rr = r & 15, cc = c & 31, ob = rr * 64 + cc * 2; return st * 1024 + (ob ^ (((ob >> 9) & 1) << 5)); }
__host__ __device__ __forceinline__ void stage_rc(int b, int& R, int& C) { const int st = b / 1024, sb = b % 1024, swz = sb ^ (((sb >> 9) & 1) << 5); R = (st >> 1) * 16 + swz / 64; C = (st & 1) * 32 + (swz % 64) / 2; }
__host__ __device__ __forceinline__ int perm32(int rho) { const int n = rho >> 4, i = rho & 15; return 8 * (i >> 2) + 4 * n + (i & 3); }

struct Unit { int pm, pn; };
struct Gemm { const bf16_t* A; const bf16_t* Bt; int M, N, K; };

struct StaticOrder {
    int nM, nN, nwg, G, c;
    __host__ __device__ void init(int M, int N, int G_, int c_) { nM = M / BM; nN = N / BM; nwg = nM * nN; G = G_; c = c_; }
    __host__ __device__ bool next(int i, Unit& u) const {
        const long L = (long)i * G + c; if (L >= nwg) return false;
        int wgid = (int)L; { const int q = nwg / NXCD, r = nwg % NXCD, xcd = wgid % NXCD, off = wgid / NXCD; wgid = (xcd < r ? xcd * (q + 1) : r * (q + 1) + (xcd - r) * q) + off; }
        const int nig = WGM * nN, gid = wgid / nig, fm = gid * WGM, gsz = (nM - fm) < WGM ? (nM - fm) : WGM;
        u.pm = fm + ((wgid % nig) % gsz); u.pn = (wgid % nig) / gsz; return true;
    }
    __device__ __forceinline__ void a_ready(const Unit&) const {}
    __device__ __forceinline__ void done(const Unit&) const {}
};


typedef float f32x2_t __attribute__((ext_vector_type(2))); typedef __bf16 bf16x2_t __attribute__((ext_vector_type(2)));
__device__ __forceinline__ unsigned cvt_pk_bf16(float lo, float hi) { f32x2_t v = {lo, hi}; bf16x2_t b = __builtin_convertvector(v, bf16x2_t); return __builtin_bit_cast(unsigned, b); }
__device__ __forceinline__ float bf_lo(unsigned w) { return __builtin_bit_cast(float, w << 16); }
__device__ __forceinline__ float bf_hi(unsigned w) { return __builtin_bit_cast(float, w & 0xffff0000u); }
__device__ __forceinline__ float sigmoidf_(float x) { return __builtin_amdgcn_rcpf(1.0f + __expf(-x)); }

struct EpiIn {
    static constexpr bool PERM = true, AFTER_DRAIN = false, HAS_MID = false;
    bf16_t *QA, *KA, *VA, *QB, *KB, *VB, *SA, *SB;
    const float *cs, *sn;
    const float *qn_a, *kn_a, *qn_b, *kn_b;
    float* kmean;
    __device__ __forceinline__ void operator()(const f32x4 (&acc)[2][2][4][2], const Unit& u, int wr, int wc, int fr, int fq) const {
        const int pn = u.pn;
        asm volatile("" : "+v"(fr), "+v"(fq));
        const int row0 = u.pm * BM + wr * 64 + fr;
        if (pn >= 9) {
            bf16_t* dst = pn < 13 ? SA : SB;
            const unsigned off0 = (unsigned)row0 * 1024u + (unsigned)(256 * (pn - (pn < 13 ? 9 : 13)) + 64 * wc + 8 * fq);
#pragma unroll
            for (int ai = 0; ai < 2; ++ai)
#pragma unroll
                for (int m = 0; m < 4; ++m) {
#pragma unroll
                    for (int bj = 0; bj < 2; ++bj) { const f32x4 v0 = acc[ai][bj][m][0], v1 = acc[ai][bj][m][1]; u32x4 w;
                        w.x = cvt_pk_bf16(sigmoidf_(v0[0]), sigmoidf_(v0[1])); w.y = cvt_pk_bf16(sigmoidf_(v0[2]), sigmoidf_(v0[3]));
                        w.z = cvt_pk_bf16(sigmoidf_(v1[0]), sigmoidf_(v1[1])); w.w = cvt_pk_bf16(sigmoidf_(v1[2]), sigmoidf_(v1[3]));
                        *(u32x4*)(dst + (off0 + (unsigned)((ai * HALF + m * 16) * 1024 + 32 * bj))) = w; } }
            return;
        }
        const int b = u.pm >> 3, srow0 = (u.pm & 7) * BM + wr * 64 + fr;
        bf16_t* dst; int head, nh; const float* gain = nullptr; bool isq = false, iskb = false;
        if (pn < 2)      { dst = QA; head = 4 * pn + wc;       nh = 8; gain = qn_a; isq = true; }
        else if (pn < 4) { dst = QB; head = 4 * (pn - 2) + wc; nh = 8; gain = qn_b; isq = true; }
        else if (pn < 6) { dst = KB; head = 4 * (pn - 4) + wc; nh = 8; gain = kn_b; iskb = true; }
        else if (pn < 8) { dst = VB; head = 4 * (pn - 6) + wc; nh = 8; }
        else if (wc < 2) { dst = KA; head = wc;     nh = 2; gain = kn_a; }
        else             { dst = VA; head = wc - 2; nh = 2; }
        const unsigned doff0 = (unsigned)(((b * nh + head) * 2048 + srow0) * 64 + 8 * fq);
        if (gain == nullptr) {
#pragma unroll
            for (int ai = 0; ai < 2; ++ai)
#pragma unroll
                for (int m = 0; m < 4; ++m) {
#pragma unroll
                    for (int bj = 0; bj < 2; ++bj) { const f32x4 v0 = acc[ai][bj][m][0], v1 = acc[ai][bj][m][1]; u32x4 w;
                        w.x = cvt_pk_bf16(v0[0], v0[1]); w.y = cvt_pk_bf16(v0[2], v0[3]); w.z = cvt_pk_bf16(v1[0], v1[1]); w.w = cvt_pk_bf16(v1[2], v1[3]);
                        *(u32x4*)(dst + (doff0 + (unsigned)((ai * HALF + m * 16) * 64 + 32 * bj))) = w; } }
            return;
        }
        f32x4 g[2][2];
#pragma unroll
        for (int bj = 0; bj < 2; ++bj)
#pragma unroll
            for (int n = 0; n < 2; ++n) g[bj][n] = *(const f32x4*)(gain + 32 * bj + 8 * fq + 4 * n);
        const float osc = isq ? 0.18033688011112042f   : 1.0f;
        f32x4 csum[2][2];
#pragma unroll
        for (int bj = 0; bj < 2; ++bj)
#pragma unroll
            for (int n = 0; n < 2; ++n) csum[bj][n] = (f32x4){0.f, 0.f, 0.f, 0.f};
#pragma unroll
        for (int ai = 0; ai < 2; ++ai)
#pragma unroll
            for (int m = 0; m < 4; ++m) {
                const unsigned toff = (unsigned)(row0 * 32 + 8 * fq) + (unsigned)((ai * HALF + m * 16) * 32);
                f32x4 v[2][2]; float ss = 0.f;
#pragma unroll
                for (int bj = 0; bj < 2; ++bj)
#pragma unroll
                    for (int n = 0; n < 2; ++n) { v[bj][n] = acc[ai][bj][m][n]; const f32x4 x = v[bj][n]; ss += (x[0] * x[0] + x[1] * x[1]) + (x[2] * x[2] + x[3] * x[3]); }
                ss += __shfl_xor(ss, 16); ss += __shfl_xor(ss, 32);
                const float rstd = rsqrtf(ss * (1.0f / 64.0f) + 1e-6f);
                f32x4 cc[2], sv[2];
#pragma unroll
                for (int n = 0; n < 2; ++n) { cc[n] = *(const f32x4*)(cs + (toff + 4u * n)); sv[n] = *(const f32x4*)(sn + (toff + 4u * n)); }
#pragma unroll
                for (int n = 0; n < 2; ++n) {
                    const f32x4 x1 = v[0][n] * rstd * g[0][n], x2 = v[1][n] * rstd * g[1][n];
                    v[0][n] = (x1 * cc[n] - x2 * sv[n]) * osc; v[1][n] = (x2 * cc[n] + x1 * sv[n]) * osc;
                    csum[0][n] += v[0][n]; csum[1][n] += v[1][n];
                }
#pragma unroll
                for (int bj = 0; bj < 2; ++bj) { const f32x4 v0 = v[bj][0], v1 = v[bj][1]; u32x4 w;
                    w.x = cvt_pk_bf16(v0[0], v0[1]); w.y = cvt_pk_bf16(v0[2], v0[3]); w.z = cvt_pk_bf16(v1[0], v1[1]); w.w = cvt_pk_bf16(v1[2], v1[3]);
                    *(u32x4*)(dst + (doff0 + (unsigned)((ai * HALF + m * 16) * 64 + 32 * bj))) = w; }
                asm volatile("" : "+v"(csum[0][0]), "+v"(csum[0][1]), "+v"(csum[1][0]), "+v"(csum[1][1]) :: "memory");
            }
        if (iskb) {
            float* km = kmean + (unsigned)(((b * 8 + head) * 8 + (u.pm & 7)) * 64 + 8 * fq);
#pragma unroll
            for (int bj = 0; bj < 2; ++bj)
#pragma unroll
                for (int n = 0; n < 2; ++n)
#pragma unroll
                    for (int i = 0; i < 4; ++i) { float t = csum[bj][n][i];
                        t += __shfl_xor(t, 1); t += __shfl_xor(t, 2); t += __shfl_xor(t, 4); t += __shfl_xor(t, 8);
                        if (fr == 0) atomicAdd(km + 32 * bj + 4 * n + i, t * (1.0f / 256.0f)); }
        }
    }
};

struct EpiMix {
    static constexpr bool PERM = true, AFTER_DRAIN = false, HAS_MID = true;
    const bf16_t *SA, *SB; bf16_t* MIX;
    __device__ __forceinline__ void mid(f32x4 (&acc)[2][2][4][2], const Unit& u, int wr, int wc, int fr, int fq) const {
        asm volatile("" : "+v"(fr), "+v"(fq));
        const unsigned off0 = (unsigned)((u.pm * BM + wr * 64 + fr) * 1024 + u.pn * BM + wc * 32 + 8 * fq);
#pragma unroll
        for (int ai = 0; ai < 2; ++ai)
#pragma unroll
            for (int m = 0; m < 4; ++m) { const unsigned off = off0 + (unsigned)((ai * HALF + m * 16) * 1024);
#pragma unroll
                for (int bj = 0; bj < 2; ++bj) { const u32x4 a = *(const u32x4*)(SA + (off + bj * HALF)), s = *(const u32x4*)(SB + (off + bj * HALF));
                    f32x4 r0, r1;
                    r0[0] = bf_lo(a.x) * __builtin_amdgcn_rcpf(fmaxf(bf_lo(s.x), 1e-20f)); r0[1] = bf_hi(a.x) * __builtin_amdgcn_rcpf(fmaxf(bf_hi(s.x), 1e-20f));
                    r0[2] = bf_lo(a.y) * __builtin_amdgcn_rcpf(fmaxf(bf_lo(s.y), 1e-20f)); r0[3] = bf_hi(a.y) * __builtin_amdgcn_rcpf(fmaxf(bf_hi(s.y), 1e-20f));
                    r1[0] = bf_lo(a.z) * __builtin_amdgcn_rcpf(fmaxf(bf_lo(s.z), 1e-20f)); r1[1] = bf_hi(a.z) * __builtin_amdgcn_rcpf(fmaxf(bf_hi(s.z), 1e-20f));
                    r1[2] = bf_lo(a.w) * __builtin_amdgcn_rcpf(fmaxf(bf_lo(s.w), 1e-20f)); r1[3] = bf_hi(a.w) * __builtin_amdgcn_rcpf(fmaxf(bf_hi(s.w), 1e-20f));
                    acc[ai][bj][m][0] *= r0; acc[ai][bj][m][1] *= r1; }
                asm volatile("" ::: "memory"); }
    }
    __device__ __forceinline__ void operator()(const f32x4 (&acc)[2][2][4][2], const Unit& u, int wr, int wc, int fr, int fq) const {
        asm volatile("" : "+v"(fr), "+v"(fq));
        const unsigned off0 = (unsigned)((u.pm * BM + wr * 64 + fr) * 1024 + u.pn * BM + wc * 32 + 8 * fq);
#pragma unroll
        for (int ai = 0; ai < 2; ++ai)
#pragma unroll
            for (int m = 0; m < 4; ++m) { const unsigned off = off0 + (unsigned)((ai * HALF + m * 16) * 1024);
#pragma unroll
                for (int bj = 0; bj < 2; ++bj) { const u32x4 s = *(const u32x4*)(SB + (off + bj * HALF)); const f32x4 v0 = acc[ai][bj][m][0], v1 = acc[ai][bj][m][1]; u32x4 w;
                    w.x = cvt_pk_bf16(v0[0] * bf_lo(s.x), v0[1] * bf_hi(s.x)); w.y = cvt_pk_bf16(v0[2] * bf_lo(s.y), v0[3] * bf_hi(s.y));
                    w.z = cvt_pk_bf16(v1[0] * bf_lo(s.z), v1[1] * bf_hi(s.z)); w.w = cvt_pk_bf16(v1[2] * bf_lo(s.w), v1[3] * bf_hi(s.w));
                    *(u32x4*)(MIX + (off + bj * HALF)) = w; }
                asm volatile("" ::: "memory"); }
    }
};

struct EpiRes {
    static constexpr bool PERM = false, AFTER_DRAIN = false, HAS_MID = false;
    const float* xin; float* xout; const float* gate;
    __device__ __forceinline__ void operator()(const f32x4 (&acc)[2][2][4][2], const Unit& u, int wr, int wc, int fr, int fq) const {
        const int row0 = u.pm * BM + wr * 64 + fr, col0 = u.pn * BM + wc * 32 + 4 * fq, b = u.pm >> 3;
        f32x4 gv[2][2];
#pragma unroll
        for (int bj = 0; bj < 2; ++bj)
#pragma unroll
            for (int n = 0; n < 2; ++n) gv[bj][n] = *(const f32x4*)(gate + (size_t)b * 6144 + col0 + bj * HALF + n * 16);
#pragma unroll
        for (int ai = 0; ai < 2; ++ai)
#pragma unroll
            for (int m = 0; m < 4; ++m) { const size_t off = (size_t)(row0 + ai * HALF + m * 16) * 1024 + col0;
#pragma unroll
                for (int bj = 0; bj < 2; ++bj)
#pragma unroll
                    for (int n = 0; n < 2; ++n) { const f32x4 xi = *(const f32x4*)(xin + off + bj * HALF + n * 16); *(f32x4*)(xout + off + bj * HALF + n * 16) = xi + gv[bj][n] * acc[ai][bj][m][n]; } }
    }
};

struct EpiUp {
    static constexpr bool PERM = true, AFTER_DRAIN = false, HAS_MID = false;
    bf16_t* H;
    __device__ __forceinline__ void operator()(const f32x4 (&acc)[2][2][4][2], const Unit& u, int wr, int wc, int fr, int fq) const {
        const int row0 = u.pm * BM + wr * 64 + fr, col0 = u.pn * BM + wc * 32 + 8 * fq;
#pragma unroll
        for (int ai = 0; ai < 2; ++ai)
#pragma unroll
            for (int m = 0; m < 4; ++m) { bf16_t* rowp = H + (size_t)(row0 + ai * HALF + m * 16) * 4096 + col0;
#pragma unroll
                for (int bj = 0; bj < 2; ++bj) { f32x4 v0 = acc[ai][bj][m][0], v1 = acc[ai][bj][m][1];
#pragma unroll
                    for (int i = 0; i < 4; ++i) { const float a = fmaxf(v0[i], 0.f), c = fmaxf(v1[i], 0.f); v0[i] = a * a; v1[i] = c * c; }
                    u32x4 w; w.x = cvt_pk_bf16(v0[0], v0[1]); w.y = cvt_pk_bf16(v0[2], v0[3]); w.z = cvt_pk_bf16(v1[0], v1[1]); w.w = cvt_pk_bf16(v1[2], v1[3]);
                    *(u32x4*)(rowp + bj * HALF) = w; } }
    }
};

template <class Epi, class Sched, bool ALIGN_EPI = false, bool SP2 = false>
__device__ __forceinline__ void gemm_phase(PG8_LAS unsigned char* lds, const Gemm g, const Sched& S, const Epi& E) {
    int tid_ = threadIdx.x; asm volatile("" : "+v"(tid_));
    const int tid = tid_, wid = __builtin_amdgcn_readfirstlane(tid >> 6), lane = tid & 63, wr = wid >> 2, wc = wid & 3, fr = lane & 15, fq = lane >> 4;
    const int K = g.K, nt = K / BK;
    unsigned voffA[2], voffB[2];
#pragma unroll
    for (int i = 0; i < 2; ++i) { int R, C; stage_rc(tid * 16 + i * 8192, R, C); const int Rb = Epi::PERM ? ((R & ~31) + perm32(R & 31)) : R;
        voffA[i] = (unsigned)(R * K + C) * 2u; voffB[i] = (unsigned)(Rb * K + C) * 2u; }
    const size_t kstep = (size_t)(BK * 2);
    const size_t hstep = (size_t)HALF * K * 2;
    const size_t tstep = 2 * hstep;
    const unsigned ldsw = (unsigned)wid * 1024u;
    const int aoff = lds_byte(wr * 64 + fr, fq * 8), boff = lds_byte(wc * 32 + fr, fq * 8);
#define PG8_SA(b, h) (((b) * 2 + (h)) * HTB)
#define PG8_SB(b, h) ((4 + (b) * 2 + (h)) * HTB)
#define PG8_STAGE(bufoff, gbase, voff) do { _Pragma("unroll") for (int _i = 0; _i < 2; ++_i) \
        __builtin_amdgcn_global_load_lds((const unsigned*)((const char*)(gbase) + (voff)[_i]), (PG8_LAS unsigned*)(lds + (bufoff) + ldsw + _i * 8192), 16, 0, 0); } while (0)
#define PG8_LDA(dst, b, h) do { _Pragma("unroll") for (int m = 0; m < 4; ++m) _Pragma("unroll") for (int k = 0; k < 2; ++k) dst[m][k] = *(const PG8_LAS bf16x8*)(lds + PG8_SA(b, h) + aoff + m * 2048 + k * 1024); } while (0)
#define PG8_LDB(dst, b, h) do { _Pragma("unroll") for (int n = 0; n < 2; ++n) _Pragma("unroll") for (int k = 0; k < 2; ++k) dst[n][k] = *(const PG8_LAS bf16x8*)(lds + PG8_SB(b, h) + boff + n * 2048 + k * 1024); } while (0)
#define PG8_MMA(ai, bj, At, Bt) do { __builtin_amdgcn_s_setprio(1); _Pragma("unroll") for (int m = 0; m < 4; ++m) _Pragma("unroll") for (int n = 0; n < 2; ++n) _Pragma("unroll") for (int k = 0; k < 2; ++k) \
        acc[ai][bj][m][n] = __builtin_amdgcn_mfma_f32_16x16x32_bf16(Bt[n][k], At[m][k], acc[ai][bj][m][n], 0, 0, 0); __builtin_amdgcn_s_setprio(0); } while (0)
#define PG8_WAIT_V(n) asm volatile("s_waitcnt vmcnt(" #n ")" ::: "memory")
#define PG8_WAIT_L(n) asm volatile("s_waitcnt lgkmcnt(" #n ")" ::: "memory")
#define PG8_BAR __builtin_amdgcn_s_barrier()
#define PG8_SCHED __builtin_amdgcn_sched_barrier(0)
    Unit cur, nxt; int ui = 0;
    if (!S.next(0, cur)) return;
    f32x4 acc[2][2][4][2];
#pragma unroll
    for (int a = 0; a < 2; ++a)
#pragma unroll
        for (int b = 0; b < 2; ++b)
#pragma unroll
            for (int m = 0; m < 4; ++m)
#pragma unroll
                for (int n = 0; n < 2; ++n) acc[a][b][m][n] = (f32x4){0.f, 0.f, 0.f, 0.f};
    bf16x8 At[4][2], B0[2][2], B1[2][2];
    const char* cA = (const char*)g.A + (size_t)cur.pm * tstep; const char* cB = (const char*)g.Bt + (size_t)cur.pn * tstep;
    S.a_ready(cur);
    if constexpr (SP2) {
        PG8_STAGE(PG8_SB(0, 0), cB, voffB); PG8_STAGE(PG8_SB(0, 1), cB + hstep, voffB); PG8_STAGE(PG8_SA(0, 0), cA, voffA); PG8_STAGE(PG8_SA(0, 1), cA + hstep, voffA);
        if (wr == 1) PG8_BAR;
        PG8_WAIT_V(2); PG8_BAR;
        PG8_STAGE(PG8_SB(1, 0), cB + kstep, voffB); PG8_STAGE(PG8_SA(1, 0), cA + kstep, voffA); PG8_STAGE(PG8_SB(1, 1), cB + hstep + kstep, voffB);
        PG8_WAIT_V(6); PG8_BAR;
    } else {
        PG8_STAGE(PG8_SB(0, 0), cB, voffB); PG8_STAGE(PG8_SA(0, 0), cA, voffA); PG8_STAGE(PG8_SB(0, 1), cB + hstep, voffB); PG8_STAGE(PG8_SA(0, 1), cA + hstep, voffA);
        if (wr == 1) PG8_BAR;
        PG8_WAIT_V(4); PG8_BAR;
        PG8_STAGE(PG8_SB(1, 0), cB + kstep, voffB); PG8_STAGE(PG8_SA(1, 0), cA + kstep, voffA); PG8_STAGE(PG8_SB(1, 1), cB + hstep + kstep, voffB);
        PG8_WAIT_V(6); PG8_BAR;
    }
    for (;;) {
        const bool has_next = S.next(ui + 1, nxt);
        const char* nA = has_next ? (const char*)g.A + (size_t)nxt.pm * tstep : cA; const char* nB = has_next ? (const char*)g.Bt + (size_t)nxt.pn * tstep : cB;
        for (int t = 0; t < nt; t += 2) {
            const bool last = (t == nt - 2);
            const char* a1 = cA + (size_t)(t + 1) * kstep;
            const char* a2 = last ? nA : cA + (size_t)(t + 2) * kstep; const char* b2 = last ? nB : cB + (size_t)(t + 2) * kstep;
            const char* a3 = a2 + kstep; const char* b3 = b2 + kstep;
            if (last && has_next) S.a_ready(nxt);
            if constexpr (SP2) {
            PG8_LDB(B0, 0, 0); PG8_LDB(B1, 0, 1); PG8_SCHED; PG8_LDA(At, 0, 0); PG8_STAGE(PG8_SA(1, 1), a1 + hstep, voffA);
            PG8_WAIT_V(8); PG8_WAIT_L(0); PG8_BAR; PG8_MMA(0, 0, At, B0); PG8_MMA(0, 1, At, B1); PG8_BAR; PG8_SCHED;
            PG8_LDA(At, 0, 1); PG8_STAGE(PG8_SB(0, 0), b2, voffB); PG8_STAGE(PG8_SB(0, 1), b2 + hstep, voffB); PG8_STAGE(PG8_SA(0, 0), a2, voffA);
            PG8_WAIT_V(8); PG8_WAIT_L(0); PG8_BAR; PG8_MMA(1, 0, At, B0); PG8_MMA(1, 1, At, B1); PG8_BAR; PG8_SCHED;
            PG8_LDB(B0, 1, 0); PG8_LDB(B1, 1, 1); PG8_SCHED; PG8_LDA(At, 1, 0); PG8_STAGE(PG8_SA(0, 1), a2 + hstep, voffA);
            PG8_WAIT_V(8); PG8_WAIT_L(0); PG8_BAR; PG8_MMA(0, 0, At, B0); PG8_MMA(0, 1, At, B1); PG8_BAR; PG8_SCHED;
            PG8_LDA(At, 1, 1); PG8_STAGE(PG8_SB(1, 0), b3, voffB); PG8_STAGE(PG8_SB(1, 1), b3 + hstep, voffB); PG8_STAGE(PG8_SA(1, 0), a3, voffA);
            PG8_WAIT_V(8); PG8_WAIT_L(0); PG8_BAR; PG8_MMA(1, 0, At, B0); PG8_MMA(1, 1, At, B1); PG8_BAR; PG8_SCHED;
            } else {
            PG8_LDB(B0, 0, 0); PG8_SCHED; PG8_LDA(At, 0, 0); PG8_STAGE(PG8_SA(1, 1), a1 + hstep, voffA);
            PG8_WAIT_L(8); PG8_BAR; PG8_WAIT_L(0); PG8_MMA(0, 0, At, B0); PG8_BAR; PG8_SCHED;
            PG8_LDB(B1, 0, 1); PG8_STAGE(PG8_SB(0, 0), b2, voffB);
            PG8_BAR; PG8_WAIT_L(0); PG8_MMA(0, 1, At, B1); PG8_BAR;
            PG8_LDA(At, 0, 1); PG8_STAGE(PG8_SA(0, 0), a2, voffA);
            PG8_BAR; PG8_WAIT_L(0); PG8_MMA(1, 0, At, B0); PG8_BAR; PG8_SCHED;
            PG8_STAGE(PG8_SB(0, 1), b2 + hstep, voffB);
            PG8_WAIT_V(6); PG8_BAR; PG8_MMA(1, 1, At, B1); PG8_BAR;
            PG8_LDB(B0, 1, 0); PG8_SCHED; PG8_LDA(At, 1, 0); PG8_STAGE(PG8_SA(0, 1), a2 + hstep, voffA);
            PG8_WAIT_L(8); PG8_BAR; PG8_WAIT_L(0); PG8_MMA(0, 0, At, B0); PG8_BAR; PG8_SCHED;
            PG8_LDB(B1, 1, 1); PG8_STAGE(PG8_SB(1, 0), b3, voffB);
            PG8_BAR; PG8_WAIT_L(0); PG8_MMA(0, 1, At, B1); PG8_BAR;
            PG8_LDA(At, 1, 1); PG8_STAGE(PG8_SA(1, 0), a3, voffA);
            PG8_BAR; PG8_WAIT_L(0); PG8_MMA(1, 0, At, B0); PG8_BAR; PG8_SCHED;
            PG8_STAGE(PG8_SB(1, 1), b3 + hstep, voffB);
            PG8_WAIT_V(6); PG8_BAR; PG8_MMA(1, 1, At, B1); PG8_BAR;
            }
            if constexpr (Epi::HAS_MID) { if (t + 2 == (nt >> 1)) E.mid(acc, cur, wr, wc, fr, fq); }
        }
        if constexpr (ALIGN_EPI) { if (wr == 0) PG8_BAR; }
        if constexpr (!Epi::AFTER_DRAIN) { E(acc, cur, wr, wc, fr, fq); S.done(cur); }
        if (!has_next) break;
#pragma unroll
        for (int a = 0; a < 2; ++a)
#pragma unroll
            for (int b = 0; b < 2; ++b)
#pragma unroll
                for (int m = 0; m < 4; ++m)
#pragma unroll
                    for (int n = 0; n < 2; ++n) acc[a][b][m][n] = (f32x4){0.f, 0.f, 0.f, 0.f};
        cur = nxt; cA = nA; cB = nB; ++ui;
        if constexpr (ALIGN_EPI) { if (wr == 1) PG8_BAR; }
    }
    PG8_WAIT_V(0);
    if constexpr (!ALIGN_EPI) { if (wr == 0) PG8_BAR; }
    PG8_BAR;
    if constexpr (Epi::AFTER_DRAIN) { E.fused(acc, cur, wr, wc, fr, fq, lds, wid, lane); S.done(cur); }
#undef PG8_SA
#undef PG8_SB
#undef PG8_STAGE
#undef PG8_LDA
#undef PG8_LDB
#undef PG8_MMA
#undef PG8_WAIT_V
#undef PG8_WAIT_L
#undef PG8_BAR
#undef PG8_SCHED
}
}

constexpr int NWAVES = 8;
constexpr int RING_OFF = 0, RING_BYTES = 131072;
constexpr int LDSCTL_OFF = RING_BYTES, MISC_OFF = LDSCTL_OFF + 320;
constexpr int LDS_BYTES = 147456;
constexpr int CW_BAR = 4096;
constexpr size_t CTL_BYTES = 65536;
constexpr size_t WS_ADAP = 232 * MiB;
typedef GAS unsigned gu32;
#define RLX_AGENT __ATOMIC_RELAXED, __HIP_MEMORY_SCOPE_AGENT
#define LDS_WAIT() asm volatile("s_waitcnt lgkmcnt(0)" ::: "memory")
#define VM_WAIT() asm volatile("s_waitcnt vmcnt(0)" ::: "memory")

#ifndef ATTN_SWA_MFMA
#define ATTN_SWA_MFMA 1
#endif
#ifndef ATTN_MOBA_MFMA
#define ATTN_MOBA_MFMA 1
#endif
#define XB_TMO      128
#define XB_XCNT(j)  (256  + 64 * (j))
#define XB_XSUB(j)  (1280 + 64 * (j))
#define XB_XGEN(j)  (2304 + 64 * (j))
#define XB_TOP      3328
#define XB_TOPGEN   3392
#define XCD_BAR_WORDS 3456
#define XB_SPIN_CAP (1u << 18)

__device__ __forceinline__ unsigned xb_ld(unsigned* p)              { return __hip_atomic_load(p, __ATOMIC_RELAXED, __HIP_MEMORY_SCOPE_AGENT); }
__device__ __forceinline__ unsigned xb_add(unsigned* p, unsigned v) { return __hip_atomic_fetch_add(p, v, __ATOMIC_RELAXED, __HIP_MEMORY_SCOPE_AGENT); }
__device__ __forceinline__ unsigned xb_xcc_id() { return (unsigned)__builtin_amdgcn_s_getreg((3 << 11) | 20) & 0xFu; }
#define XB_SPIN(cond, bar) do { unsigned _sp = 0; while (cond) { __builtin_amdgcn_s_sleep(1); \
    if ((++_sp & 255u) == 0u) { if (xb_ld(&(bar)[XB_TMO])) break; if (_sp > XB_SPIN_CAP) { atomicAdd(&(bar)[XB_TMO], 1u); break; } } } } while (0)

struct XcdBarrier {
    unsigned* bar; unsigned x;
    volatile LAS unsigned* st;
};

__device__ __forceinline__ XcdBarrier xcd_barrier_post(unsigned* bar, volatile LAS unsigned* st) {
    XcdBarrier b; b.bar = bar; b.x = (unsigned)__builtin_amdgcn_readfirstlane((int)xb_xcc_id()); b.st = st;
    if (threadIdx.x == 0) (void)xb_add(&bar[XB_XCNT(b.x)], 1u);
    return b;
}
__device__ __forceinline__ void xcd_barrier_complete(unsigned* bar, unsigned x, unsigned& nloc, unsigned& nx) {
    const unsigned G = gridDim.x * gridDim.y * gridDim.z;
    unsigned sum, cnt, mine, sp = 0u;
    for (;;) {
        sum = 0u; cnt = 0u; mine = 0u;
#pragma unroll
        for (unsigned j = 0; j < 16; ++j) { const unsigned c = xb_ld(&bar[XB_XCNT(j)]); sum += c; cnt += (c > 0u) ? 1u : 0u; mine = (j == x) ? c : mine; }
        if (sum == G) break;
        __builtin_amdgcn_s_sleep(1);
        if ((++sp & 255u) == 0u) { if (xb_ld(&bar[XB_TMO])) break; if (sp > XB_SPIN_CAP) { atomicAdd(&bar[XB_TMO], 1u); break; } }
    }
    nloc = mine > 0u ? mine : 1u; nx = cnt > 0u ? cnt : 1u;
}

__device__ __forceinline__ void xcd_barrier(const XcdBarrier& b) {
    asm volatile("s_waitcnt vmcnt(0)" ::: "memory");
    __syncthreads();
    if (threadIdx.x == 0) {
        unsigned* bar = b.bar;
        __builtin_amdgcn_s_waitcnt(0);
        unsigned nloc = b.st[0], nx = b.st[1];
        if (nloc == 0u) { xcd_barrier_complete(bar, b.x, nloc, nx); b.st[0] = nloc; b.st[1] = nx; }
        const unsigned old = xb_add(&bar[XB_XSUB(b.x)], 1u);
        const unsigned gen = old / nloc;
        if (old + 1u == (gen + 1u) * nloc) {
            __builtin_amdgcn_fence(__ATOMIC_RELEASE, "agent");
            asm volatile("s_waitcnt vmcnt(0)" ::: "memory");
            const unsigned og = xb_add(&bar[XB_TOP], 1u);
            const unsigned tg = og / nx;
            if (og + 1u == (tg + 1u) * nx) xb_add(&bar[XB_TOPGEN], 1u);
            else XB_SPIN(xb_ld(&bar[XB_TOPGEN]) == tg, bar);
            __builtin_amdgcn_fence(__ATOMIC_ACQUIRE, "agent");
            xb_add(&bar[XB_XGEN(b.x)], 1u);
            asm volatile("s_waitcnt vmcnt(0)" ::: "memory");
        } else {
            XB_SPIN(xb_ld(&bar[XB_XGEN(b.x)]) == gen, bar);
            __builtin_amdgcn_fence(__ATOMIC_ACQUIRE, "agent");
            asm volatile("s_waitcnt vmcnt(0)" ::: "memory");
        }
    }
    __syncthreads();
}

namespace att {
typedef float f32x16 __attribute__((ext_vector_type(16)));
typedef short bf16x8 __attribute__((ext_vector_type(8)));
typedef short s16x4 __attribute__((ext_vector_type(4)));
typedef short v4i16_t __attribute__((ext_vector_type(4)));
typedef float f32x2_t __attribute__((ext_vector_type(2))); typedef __bf16 bf16x2_t __attribute__((ext_vector_type(2)));
typedef LAS const unsigned char* lcp;
constexpr int SLOTB = 16384;
constexpr int L_WSF = 2 * SLOTB;
constexpr int L_OST = L_WSF + 8 * 256;
constexpr int L_END = L_OST + 8 * 4096;
__device__ __forceinline__ int crow(int r, int hi) { return (r & 3) + 8 * (r >> 2) + 4 * hi; }
__device__ __forceinline__ unsigned cvtpk(float lo, float hi) { f32x2_t v = {lo, hi}; bf16x2_t b = __builtin_convertvector(v, bf16x2_t); return __builtin_bit_cast(unsigned, b); }
__device__ __forceinline__ s16x4 vtr(lcp p) { return __builtin_bit_cast(s16x4, __builtin_amdgcn_ds_read_tr16_b64_v4i16((LAS v4i16_t*)p)); }

__device__ __forceinline__ void stage_tile(LAS unsigned char* slot, const bf16* kt, const bf16* vt, int wid, int lane) {
    __builtin_amdgcn_global_load_lds((const unsigned*)(kt + lane * 64 + wid * 8), (LAS unsigned*)(slot + wid * 1024), 16, 0, 0);
    __builtin_amdgcn_global_load_lds((const unsigned*)(vt + (16 * (wid & 3) + (lane >> 2)) * 64 + (wid >> 2) * 32 + (lane & 3) * 8), (LAS unsigned*)(slot + 8192 + wid * 1024), 16, 0, 0);
}

__device__ __forceinline__ void tile_step(lcp slot, const bf16x8 (&qr)[4], f32x16 (&o)[2], float& m, float& l, LAS float* wsf, int r32, int hi, int lane, int mode, int qq, bool dead) {
    const float NEG = -INFINITY;
    f32x16 p0, p1;
    {   lcp kb = slot + hi * 1024 + r32 * 16;
#pragma unroll
        for (int r = 0; r < 16; ++r) { p0[r] = 0.f; p1[r] = 0.f; }
#pragma unroll
        for (int d0 = 0; d0 < 4; ++d0) {
            const bf16x8 b0 = *(LAS const bf16x8*)(kb + d0 * 2048), b1 = *(LAS const bf16x8*)(kb + d0 * 2048 + 512);
            p0 = __builtin_amdgcn_mfma_f32_32x32x16_bf16(b0, qr[d0], p0, 0, 0, 0);
            p1 = __builtin_amdgcn_mfma_f32_32x32x16_bf16(b1, qr[d0], p1, 0, 0, 0); } }
    if (mode == 1) {
#pragma unroll
        for (int r = 0; r < 16; ++r) { const int kv = crow(r, hi); if (kv > qq) p0[r] = NEG; if (kv + 32 > qq) p1[r] = NEG; } }
    else if (mode == 2) {
#pragma unroll
        for (int r = 0; r < 16; ++r) { const int kv = crow(r, hi); if (kv <= qq) p0[r] = NEG; if (kv + 32 <= qq) p1[r] = NEG; } }
    if (dead) {
#pragma unroll
        for (int r = 0; r < 16; ++r) { p0[r] = NEG; p1[r] = NEG; } }
    float rm = fmaxf(p0[0], p1[0]);
#pragma unroll
    for (int r = 1; r < 16; ++r) rm = fmaxf(rm, fmaxf(p0[r], p1[r]));
    rm = fmaxf(rm, __shfl_xor(rm, 32));
    const float mn = fmaxf(m, rm);
    if (__any(mn > m)) {
        const float alpha = __builtin_amdgcn_exp2f(m - mn);
        l *= alpha;
        if (hi == 0) wsf[r32] = alpha;
        asm volatile("s_waitcnt lgkmcnt(0)" ::: "memory");
#pragma unroll
        for (int r = 0; r < 16; ++r) { const float f = wsf[crow(r, hi)]; o[0][r] *= f; o[1][r] *= f; }
        asm volatile("" ::: "memory");
    }
    m = mn;
    float ls = 0.f;
#pragma unroll
    for (int r = 0; r < 16; ++r) { p0[r] = __builtin_amdgcn_exp2f(p0[r] - mn); p1[r] = __builtin_amdgcn_exp2f(p1[r] - mn); ls += p0[r] + p1[r]; }
    l += ls;
    bf16x8 pa[4];
#pragma unroll
    for (int k = 0; k < 2; ++k) {
        const unsigned a0 = cvtpk(p0[8 * k + 0], p0[8 * k + 1]), a1 = cvtpk(p0[8 * k + 2], p0[8 * k + 3]), a2 = cvtpk(p0[8 * k + 4], p0[8 * k + 5]), a3 = cvtpk(p0[8 * k + 6], p0[8 * k + 7]);
        const unsigned c0 = cvtpk(p1[8 * k + 0], p1[8 * k + 1]), c1 = cvtpk(p1[8 * k + 2], p1[8 * k + 3]), c2 = cvtpk(p1[8 * k + 4], p1[8 * k + 5]), c3 = cvtpk(p1[8 * k + 6], p1[8 * k + 7]);
        pa[k] = __builtin_bit_cast(bf16x8, (v4u){a0, a1, a2, a3}); pa[2 + k] = __builtin_bit_cast(bf16x8, (v4u){c0, c1, c2, c3}); }
    lcp vp = slot + 8192 + ((lane >> 4) & 1) * 32 + (lane & 3) * 8 + (4 * hi + ((lane & 15) >> 2)) * 64;
#pragma unroll
    for (int d0 = 0; d0 < 2; ++d0)
#pragma unroll
        for (int ks = 0; ks < 4; ++ks) {
            const s16x4 lo = vtr(vp + d0 * 4096 + ks * 1024), hh = vtr(vp + d0 * 4096 + ks * 1024 + 512);
            const bf16x8 vf = (bf16x8){lo[0], lo[1], lo[2], lo[3], hh[0], hh[1], hh[2], hh[3]};
            o[d0] = __builtin_amdgcn_mfma_f32_32x32x16_bf16(pa[ks], vf, o[d0], 0, 0, 0); }
}

__device__ __forceinline__ void finish(f32x16 (&o)[2], float m, float l, float sink_l2, bool has_sink, LAS float* wsf, LAS bf16* stg, bf16* orow0, int r32, int hi, int lane) {
    l += __shfl_xor(l, 32);
    if (has_sink) l += __builtin_amdgcn_exp2f(sink_l2 - m);
    if (hi == 0) wsf[32 + r32] = 1.0f / l;
    asm volatile("s_waitcnt lgkmcnt(0)" ::: "memory");
#pragma unroll
    for (int r = 0; r < 16; ++r) { const int orow = crow(r, hi); const float f = wsf[32 + orow];
        stg[orow * 64 + r32] = (bf16)f2bf(o[0][r] * f); stg[orow * 64 + 32 + r32] = (bf16)f2bf(o[1][r] * f); }
    asm volatile("s_waitcnt lgkmcnt(0)" ::: "memory");
#pragma unroll
    for (int i = 0; i < 4; ++i) { const int row = i * 8 + (lane >> 3), ch = lane & 7; const v4u v = *(LAS const v4u*)(stg + row * 64 + ch * 8); *(v4u*)(orow0 + (size_t)row * 1024 + ch * 8) = v; }
    asm volatile("s_waitcnt lgkmcnt(0)" ::: "memory");
}

__device__ __forceinline__ void swa_unit(LAS unsigned char* lds, int i, const bf16* QA, const bf16* KA, const bf16* VA, const float* sinks, bf16* OAB) {
    int tid_ = threadIdx.x; asm volatile("" : "+v"(tid_));
    const int lane = tid_ & 63, wid = __builtin_amdgcn_readfirstlane(tid_ >> 6), r32 = lane & 31, hi = lane >> 5;
    const int b = i >> 6, kvh = (i >> 5) & 1, c = i & 31, hq = 4 * kvh + (wid >> 1), qq = 32 * (wid & 1) + r32;
    const bf16* qp = QA + ((size_t)(b * 8 + hq) * 2048 + 64 * c + qq) * 64 + 8 * hi;
    const bf16* kbase = KA + (size_t)(b * 2 + kvh) * 2048 * 64; const bf16* vbase = VA + (size_t)(b * 2 + kvh) * 2048 * 64;
    const int nt = c >= 2 ? 3 : c + 1;
    stage_tile(lds, kbase + (size_t)(64 * c) * 64, vbase + (size_t)(64 * c) * 64, wid, lane);
    bf16x8 qr[4];
#pragma unroll
    for (int d0 = 0; d0 < 4; ++d0) qr[d0] = *(const bf16x8*)(qp + 16 * d0);
    f32x16 o[2];
#pragma unroll
    for (int r = 0; r < 16; ++r) { o[0][r] = 0.f; o[1][r] = 0.f; }
    float m = -1e30f, l = 0.f;
    LAS float* wsf = (LAS float*)(lds + L_WSF) + wid * 64;
    for (int t = 0; t < nt; ++t) {
        asm volatile("s_waitcnt vmcnt(0)" ::: "memory"); __syncthreads();
        if (t + 1 < nt) stage_tile(lds + ((t + 1) & 1) * SLOTB, kbase + (size_t)(64 * (c - t - 1)) * 64, vbase + (size_t)(64 * (c - t - 1)) * 64, wid, lane);
        tile_step(lds + (t & 1) * SLOTB, qr, o, m, l, wsf, r32, hi, lane, t == 0 ? 1 : (t == 1 ? 0 : 2), qq, false);
    }
    finish(o, m, l, sinks[hq] * LOG2E, true, wsf, (LAS bf16*)(lds + L_OST) + wid * 2048, OAB + (size_t)(b * 2048 + 64 * c + 32 * (wid & 1)) * 1024 + 64 * hq, r32, hi, lane);
    __syncthreads();
}

__device__ __forceinline__ void moba_unit(LAS unsigned char* lds, int bh, int qb, const bf16* QB, const bf16* KB, const bf16* VB, const float* kmean, bf16* OAB) {
    int tid_ = threadIdx.x; asm volatile("" : "+v"(tid_));
    const int lane = tid_ & 63, wid = __builtin_amdgcn_readfirstlane(tid_ >> 6), r32 = lane & 31, hi = lane >> 5;
    const int qrel = 32 * wid + r32;
    const bf16* qp = QB + ((size_t)bh * 2048 + 256 * qb + qrel) * 64 + 8 * hi;
    const bf16* kbase = KB + (size_t)bh * 2048 * 64; const bf16* vbase = VB + (size_t)bh * 2048 * 64;
    const int nt = 4 * (qb + 1);
    stage_tile(lds, kbase + (size_t)(256 * qb) * 64, vbase + (size_t)(256 * qb) * 64, wid, lane);
    bf16x8 qr[4];
#pragma unroll
    for (int d0 = 0; d0 < 4; ++d0) qr[d0] = *(const bf16x8*)(qp + 16 * d0);
    unsigned selmask = 0u;
    {   float gate[8];
        const float* km = kmean + (size_t)bh * 8 * 64 + 8 * hi;
#pragma unroll
        for (int n = 0; n < 8; ++n) { float g = 0.f;
            if (n < qb) {
#pragma unroll
                for (int d0 = 0; d0 < 4; ++d0) { const float4 k0 = *(const float4*)(km + n * 64 + 16 * d0), k1 = *(const float4*)(km + n * 64 + 16 * d0 + 4); const v4u w = __builtin_bit_cast(v4u, qr[d0]);
                    g += bflo(w.x) * k0.x + bfhi(w.x) * k0.y + bflo(w.y) * k0.z + bfhi(w.y) * k0.w + bflo(w.z) * k1.x + bfhi(w.z) * k1.y + bflo(w.w) * k1.z + bfhi(w.w) * k1.w; } }
            g += __shfl_xor(g, 32); gate[n] = g; }
#pragma unroll
        for (int n = 0; n < 8; ++n) { int rank = 0;
#pragma unroll
            for (int mm = 0; mm < 8; ++mm) { if (mm != n) { const bool ahead = (gate[mm] > gate[n]) || (gate[mm] == gate[n] && mm < n); rank += (mm < qb && ahead) ? 1 : 0; } }
            if (n < qb && rank < 3) selmask |= 1u << n; } }
    f32x16 o[2];
#pragma unroll
    for (int r = 0; r < 16; ++r) { o[0][r] = 0.f; o[1][r] = 0.f; }
    float m = -1e30f, l = 0.f;
    LAS float* wsf = (LAS float*)(lds + L_WSF) + wid * 64;
    for (int t = 0; t < nt; ++t) {
        asm volatile("s_waitcnt vmcnt(0)" ::: "memory"); __syncthreads();
        if (t + 1 < nt) { const int t1 = t + 1; const int krow = t1 < 4 ? 256 * qb + 64 * t1 : 64 * (t1 - 4);
            stage_tile(lds + (t1 & 1) * SLOTB, kbase + (size_t)krow * 64, vbase + (size_t)krow * 64, wid, lane); }
        if (t < 4) { if (64 * t <= 32 * wid + 31) tile_step(lds + (t & 1) * SLOTB, qr, o, m, l, wsf, r32, hi, lane, (64 * t + 63 <= 32 * wid) ? 0 : 1, qrel - 64 * t, false); }
        else { const int n = (t - 4) >> 2; const bool sel = (selmask >> n) & 1u; if (__any(sel)) tile_step(lds + (t & 1) * SLOTB, qr, o, m, l, wsf, r32, hi, lane, 0, 0, !sel); }
    }
    finish(o, m, l, 0.f, false, wsf, (LAS bf16*)(lds + L_OST) + wid * 2048, OAB + ((size_t)(bh >> 3) * 2048 + 256 * qb + 32 * wid) * 1024 + 512 + 64 * (bh & 7), r32, hi, lane);
    __syncthreads();
}
}

__device__ __forceinline__ float wave_sum(float v) {
#pragma unroll
    for (int o = 1; o < 64; o <<= 1) v += __shfl_xor(v, o);
    return v;
}

template <bool PERMIN>
__device__ __forceinline__ void transpose_item(const float* W, int K, int N, bf16* WT, int ldk, int koff, LAS float* scr, int item, int lane) {
    const int nblk = N / 32, kb = item / nblk, nb = item % nblk, k0 = 64 * kb, n0 = 32 * nb;
#pragma unroll 8
    for (int i = 0; i < 32; ++i) { const int kk = 2 * i + (lane >> 5); scr[kk * 33 + (lane & 31)] = W[(size_t)(k0 + kk) * N + n0 + (lane & 31)]; }
    LDS_WAIT(); asm volatile("" ::: "memory");
    const int c = lane & 7;
#pragma unroll
    for (int j = 0; j < 4; ++j) { const int n = (lane >> 3) + 8 * j; const LAS float* s = scr + (8 * c) * 33 + n;
        v4u o; o.x = pk2(s[0 * 33], s[1 * 33]); o.y = pk2(s[2 * 33], s[3 * 33]); o.z = pk2(s[4 * 33], s[5 * 33]); o.w = pk2(s[6 * 33], s[7 * 33]);
        const int prow = PERMIN ? in_rowmap(n0 + n) : (n0 + n);
        *(GAS v4u*)(WT + (size_t)prow * ldk + koff + k0 + 8 * c) = o; }
    LDS_WAIT(); asm volatile("" ::: "memory");
}

__device__ __forceinline__ void norm_row(const float* xrow, const float* g, const float* sh, const float* sc, bf16* orow, int lane) {
    typedef float f32x4 __attribute__((ext_vector_type(4)));
    const GAS f32x4* xr = (const GAS f32x4*)xrow + lane;
    f32x4 v[4]; float s = 0.f;
#pragma unroll
    for (int j = 0; j < 4; ++j) { v[j] = xr[64 * j]; s += (v[j].x * v[j].x + v[j].y * v[j].y) + (v[j].z * v[j].z + v[j].w * v[j].w); }
    const float rstd = rsqrtf(wave_sum(s) * (1.f / DM) + NORM_EPS);
    GAS unsigned long long* o8 = (GAS unsigned long long*)orow + lane;
#pragma unroll
    for (int j = 0; j < 4; ++j) {
        const f32x4 gg = ((const GAS f32x4*)g)[lane + 64 * j], hh = ((const GAS f32x4*)sh)[lane + 64 * j], cc = ((const GAS f32x4*)sc)[lane + 64 * j];
        const f32x4 y = v[j] * rstd * gg * (cc + 1.0f) + hh;
        o8[64 * j] = (unsigned long long)pk2(y.x, y.y) | ((unsigned long long)pk2(y.z, y.w) << 32);
    }
}

__device__ __forceinline__ void ld8(const bf16* p, float* o) {
    const v4u w = *(const v4u*)p;
    o[0] = bflo(w.x); o[1] = bfhi(w.x); o[2] = bflo(w.y); o[3] = bfhi(w.y); o[4] = bflo(w.z); o[5] = bfhi(w.z); o[6] = bflo(w.w); o[7] = bfhi(w.w);
}
__device__ __forceinline__ void swa_naive_item(int idx, const bf16* QA, const bf16* KA, const bf16* VA, const float* sinks, bf16* OAB) {
    const int s = idx & 2047, hq = (idx >> 11) & 7, b = idx >> 14, kvh = hq >> 2;
    float q[64], o[64];
    const bf16* qp = QA + ((size_t)(b * 8 + hq) * 2048 + s) * 64;
#pragma unroll
    for (int c = 0; c < 8; ++c) ld8(qp + 8 * c, q + 8 * c);
#pragma unroll
    for (int d = 0; d < 64; ++d) o[d] = 0.f;
    float m = -1e30f, l = 0.f;
    const bf16* kbase = KA + ((size_t)(b * 2 + kvh) * 2048) * 64; const bf16* vbase = VA + ((size_t)(b * 2 + kvh) * 2048) * 64;
    const int klo = s - 127 > 0 ? s - 127 : 0;
    for (int k = klo; k <= s; ++k) {
        float sc = 0.f;
#pragma unroll
        for (int c = 0; c < 8; ++c) { float kv[8]; ld8(kbase + (size_t)k * 64 + 8 * c, kv);
#pragma unroll
            for (int j = 0; j < 8; ++j) sc += q[8 * c + j] * kv[j]; }
        const float mn = fmaxf(m, sc), al = exp2f(m - mn), p = exp2f(sc - mn);
        l = l * al + p; m = mn;
#pragma unroll
        for (int c = 0; c < 8; ++c) { float vv[8]; ld8(vbase + (size_t)k * 64 + 8 * c, vv);
#pragma unroll
            for (int j = 0; j < 8; ++j) o[8 * c + j] = o[8 * c + j] * al + p * vv[j]; }
    }
    l += exp2f(sinks[hq] * LOG2E - m);
    const float inv = 1.0f / l;
    bf16* op = OAB + (size_t)(b * 2048 + s) * 1024 + hq * 64;
#pragma unroll
    for (int c = 0; c < 8; ++c) { v4u w; w.x = pk2(o[8 * c] * inv, o[8 * c + 1] * inv); w.y = pk2(o[8 * c + 2] * inv, o[8 * c + 3] * inv); w.z = pk2(o[8 * c + 4] * inv, o[8 * c + 5] * inv); w.w = pk2(o[8 * c + 6] * inv, o[8 * c + 7] * inv);
        *(v4u*)(op + 8 * c) = w; }
}
__device__ __forceinline__ void moba_naive_item(int idx, const bf16* QB, const bf16* KB, const bf16* VB, const float* kmean, bf16* OAB) {
    const int s = idx & 2047, h = (idx >> 11) & 7, b = idx >> 14, qb = s >> 8;
    float q[64], o[64];
    const bf16* qp = QB + ((size_t)(b * 8 + h) * 2048 + s) * 64;
#pragma unroll
    for (int c = 0; c < 8; ++c) ld8(qp + 8 * c, q + 8 * c);
#pragma unroll
    for (int d = 0; d < 64; ++d) o[d] = 0.f;
    float gate[8];
    const float* km = kmean + (size_t)((b * 8 + h) * 8) * 64;
#pragma unroll
    for (int n = 0; n < 8; ++n) { float gsum = 0.f;
        if (n < qb) {
#pragma unroll
            for (int d = 0; d < 64; ++d) gsum += q[d] * km[n * 64 + d]; }
        gate[n] = gsum; }
    unsigned selmask = 0u;
#pragma unroll
    for (int n = 0; n < 8; ++n) { int rank = 0;
#pragma unroll
        for (int mm = 0; mm < 8; ++mm) { if (mm != n) { const bool ahead = (gate[mm] > gate[n]) || (gate[mm] == gate[n] && mm < n); rank += (mm < qb && ahead) ? 1 : 0; } }
        if (n < qb && rank < 3) selmask |= 1u << n; }
    selmask |= 1u << qb;
    float m = -1e30f, l = 0.f;
    const bf16* kbase = KB + ((size_t)(b * 8 + h) * 2048) * 64; const bf16* vbase = VB + ((size_t)(b * 8 + h) * 2048) * 64;
    for (int n = 0; n <= qb; ++n) {
        if (!((selmask >> n) & 1u)) continue;
        const int kend = (n == qb) ? s : (n * 256 + 255);
        for (int k = n * 256; k <= kend; ++k) {
            float sc = 0.f;
#pragma unroll
            for (int c = 0; c < 8; ++c) { float kv[8]; ld8(kbase + (size_t)k * 64 + 8 * c, kv);
#pragma unroll
                for (int j = 0; j < 8; ++j) sc += q[8 * c + j] * kv[j]; }
            const float mn = fmaxf(m, sc), al = exp2f(m - mn), p = exp2f(sc - mn);
            l = l * al + p; m = mn;
#pragma unroll
            for (int c = 0; c < 8; ++c) { float vv[8]; ld8(vbase + (size_t)k * 64 + 8 * c, vv);
#pragma unroll
                for (int j = 0; j < 8; ++j) o[8 * c + j] = o[8 * c + j] * al + p * vv[j]; }
        }
    }
    const float inv = 1.0f / l;
    bf16* op = OAB + (size_t)(b * 2048 + s) * 1024 + 512 + h * 64;
#pragma unroll
    for (int c = 0; c < 8; ++c) { v4u w; w.x = pk2(o[8 * c] * inv, o[8 * c + 1] * inv); w.y = pk2(o[8 * c + 2] * inv, o[8 * c + 3] * inv); w.z = pk2(o[8 * c + 4] * inv, o[8 * c + 5] * inv); w.w = pk2(o[8 * c + 6] * inv, o[8 * c + 7] * inv);
        *(v4u*)(op + 8 * c) = w; }
}

struct MArgs { const void* in[18]; float* out; unsigned char* ws; };
__global__ void __launch_bounds__(NWAVES * 64, 2) mega_fwd(MArgs a) {
    extern __shared__ __attribute__((aligned(16))) unsigned char lds_raw[];
    LAS unsigned char* lds = (LAS unsigned char*)lds_raw;
    volatile LAS unsigned* MISC = (volatile LAS unsigned*)(lds + MISC_OFF);
    const int G = gridDim.x, bx = blockIdx.x, vcu = (G % 8 == 0) ? (bx % 8) * (G / 8) + bx / 8 : bx;
    const int NGW = G * NWAVES, NGT = G * NWAVES * 64;
#define FRESH_IDS() int tid_ = threadIdx.x; asm volatile("" : "+v"(tid_)); const int tid = tid_, lane = tid & 63, wave = __builtin_amdgcn_readfirstlane(tid >> 6), gw = vcu * NWAVES + wave, gt = vcu * (NWAVES * 64) + tid; (void)lane; (void)gw; (void)gt; (void)wave
    unsigned char* ws = a.ws; float* out = a.out;
    const float* x = (const float*)a.in[0]; const float* cvec = (const float*)a.in[1]; const int* pos = (const int*)a.in[2];
    const float* rms_mix = (const float*)a.in[3]; const float* rms_mlp = (const float*)a.in[4];
    const float* w_ada = (const float*)a.in[5]; const float* b_ada = (const float*)a.in[6];
    const float* qn_a = (const float*)a.in[8]; const float* kn_a = (const float*)a.in[9]; const float* qn_b = (const float*)a.in[10]; const float* kn_b = (const float*)a.in[11];
    const float* sinks = (const float*)a.in[12];
    float* cs = (float*)(ws + WS_COS); float* sn = (float*)(ws + WS_SIN); float* mod = (float*)(ws + WS_MOD); float* kmean = (float*)(ws + WS_KMEAN); float* adap = (float*)(ws + WS_ADAP);
    bf16* XN = (bf16*)(ws + WS_XN); bf16* OAB = XN;
    bf16 *QA = (bf16*)(ws + WS_QA), *QB = (bf16*)(ws + WS_QB), *KB = (bf16*)(ws + WS_KB), *VB = (bf16*)(ws + WS_VB), *KA = (bf16*)(ws + WS_KA), *VA = (bf16*)(ws + WS_VA);
    bf16 *MIX = (bf16*)(ws + WS_MIX), *SA = (bf16*)(ws + WS_SA), *SB = (bf16*)(ws + WS_SB), *H = (bf16*)(ws + WS_H);

    for (int u = threadIdx.x; u < (LDS_BYTES - LDSCTL_OFF) / 4; u += NWAVES * 64) ((LAS unsigned*)(lds + LDSCTL_OFF))[u] = 0u;
    __syncthreads();
    XcdBarrier bar = xcd_barrier_post((unsigned*)(ws + WS_CTL) + CW_BAR, MISC + 8);
#define GRID_BAR() do { XcdBarrier b_ = bar; asm volatile("" : "+s"(b_.bar), "+s"(b_.x)); xcd_barrier(b_); } while (0)

    {
        FRESH_IDS();
        LAS float* silu = (LAS float*)(lds + 98304);
        for (int i = tid; i < NB * DM; i += NWAVES * 64) { const float v = cvec[i]; silu[i] = v / (1.0f + __expf(-v)); }
        __syncthreads();
        for (int it = gw; it < NLAYER * 96 * 8; it += NGW) {
            const int kc = it & 7, cc = (it >> 3) % 96, l = it / (8 * 96), j = cc * 64 + lane;
            const float* w = w_ada + ((size_t)l * DM + kc * 128) * 6144 + j;
            float acc[NB];
#pragma unroll
            for (int b = 0; b < NB; ++b) acc[b] = 0.f;
#pragma unroll 4
            for (int k = 0; k < 128; ++k) { const float wv = w[(size_t)k * 6144];
#pragma unroll
                for (int b = 0; b < NB; ++b) acc[b] += silu[b * DM + kc * 128 + k] * wv; }
#pragma unroll
            for (int b = 0; b < NB; ++b) adap[(((size_t)kc * NLAYER + l) * NB + b) * 6144 + j] = acc[b];
        }
        LAS float* scr = (LAS float*)(lds + wave * 8704);
        const float* w_in = (const float*)a.in[7]; const float* w_o_swa = (const float*)a.in[13]; const float* w_o_moba = (const float*)a.in[14];
        const float* w_out = (const float*)a.in[15]; const float* w_up = (const float*)a.in[16]; const float* w_down = (const float*)a.in[17];
        constexpr int I_IN = (DM / 64) * (INW / 32), I_OS = (512 / 64) * (DM / 32), I_OUT = (DM / 64) * (DM / 32), I_UP = (DM / 64) * (FFD / 32), I_DN = (FFD / 64) * (DM / 32);
        constexpr int PER_L = I_IN + 2 * I_OS + I_OUT + I_UP + I_DN;
        for (int it = gw; it < NLAYER * PER_L; it += NGW) {
            const int l = it / PER_L; int r = it % PER_L;
            if (r < I_IN) { transpose_item<true>(w_in + (size_t)l * DM * INW, DM, INW, (bf16*)(ws + WS_WIN + l * WIN_BYTES), DM, 0, scr, r, lane); continue; } r -= I_IN;
            if (r < I_OS) { transpose_item<false>(w_o_swa + (size_t)l * 512 * DM, 512, DM, (bf16*)(ws + WS_WO + l * WO_BYTES), DM, 0, scr, r, lane); continue; } r -= I_OS;
            if (r < I_OS) { transpose_item<false>(w_o_moba + (size_t)l * 512 * DM, 512, DM, (bf16*)(ws + WS_WO + l * WO_BYTES), DM, 512, scr, r, lane); continue; } r -= I_OS;
            if (r < I_OUT) { transpose_item<false>(w_out + (size_t)l * DM * DM, DM, DM, (bf16*)(ws + WS_WOUT + l * WOUT_BYTES), DM, 0, scr, r, lane); continue; } r -= I_OUT;
            if (r < I_UP) { transpose_item<false>(w_up + (size_t)l * DM * FFD, DM, FFD, (bf16*)(ws + WS_WUP + l * WUP_BYTES), DM, 0, scr, r, lane); continue; } r -= I_UP;
            transpose_item<false>(w_down + (size_t)l * FFD * DM, FFD, DM, (bf16*)(ws + WS_WDN + l * WDN_BYTES), FFD, 0, scr, r, lane);
        }
        for (int i = gt; i < M_TOK * 32; i += NGT) { const int m = i >> 5, d = i & 31; const float inv = powf(10000.0f, -(float)d / 32.0f); const float ang = (float)pos[m] * inv; cs[i] = cosf(ang); sn[i] = sinf(ang); }
        for (int i = gt; i < (int)(NLAYER * KMEAN_BYTES_L / 4); i += NGT) kmean[i] = 0.f;
    }
    GRID_BAR();
    { FRESH_IDS();
      for (int i = gt; i < NLAYER * NB * 6144; i += NGT) { const int j = i % 6144, l = i / (NB * 6144); float s = b_ada[l * 6144 + j];
#pragma unroll
        for (int kc = 0; kc < 8; ++kc) s += adap[(size_t)kc * (NLAYER * NB * 6144) + i];
        mod[i] = s; } }
    GRID_BAR();

#pragma nounroll
    for (int l = 0; l < NLAYER; ++l) {
        const float* xin = (l == 0) ? x : out;
        const float* modl = mod + (size_t)l * NB * 6144;
        float* kml = kmean + (size_t)l * (KMEAN_BYTES_L / 4);
        { FRESH_IDS();
        for (int m = gw; m < M_TOK; m += NGW) { const int b = m >> 11; norm_row(xin + (size_t)m * DM, rms_mix + l * DM, modl + (size_t)b * 6144, modl + (size_t)b * 6144 + 1024, XN + (size_t)m * DM, lane); } }
        GRID_BAR();
        { pg8::Gemm g{XN, (const bf16*)(ws + WS_WIN + l * WIN_BYTES), M_TOK, INW, DM}; pg8::StaticOrder S; S.init(M_TOK, INW, G, bx);
          pg8::EpiIn E; E.QA = QA; E.KA = KA; E.VA = VA; E.QB = QB; E.KB = KB; E.VB = VB; E.SA = SA; E.SB = SB; E.cs = cs; E.sn = sn;
          E.qn_a = qn_a + l * 64; E.kn_a = kn_a + l * 64; E.qn_b = qn_b + l * 64; E.kn_b = kn_b + l * 64; E.kmean = kml;
          pg8::gemm_phase<pg8::EpiIn, pg8::StaticOrder, true, true>(lds + RING_OFF, g, S, E); }
        GRID_BAR();
#if ATTN_SWA_MFMA
        for (int i = vcu; i < NB * 2 * 32; i += G) att::swa_unit(lds, i, QA, KA, VA, sinks + l * 8, OAB);
#else
        { FRESH_IDS();
        for (int i = gt; i < NB * 8 * SEQ; i += NGT) swa_naive_item(i, QA, KA, VA, sinks + l * 8, OAB); }
#endif
#if ATTN_MOBA_MFMA
        for (int i = vcu; i < NB * 8 * 4; i += G) { const int bh = i >> 2, p = i & 3; att::moba_unit(lds, bh, p, QB, KB, VB, kml, OAB); att::moba_unit(lds, bh, 7 - p, QB, KB, VB, kml, OAB); }
#else
        { FRESH_IDS();
        for (int i = gt; i < NB * 8 * SEQ; i += NGT) moba_naive_item(i, QB, KB, VB, kml, OAB); }
#endif
        GRID_BAR();
        { pg8::Gemm g{OAB, (const bf16*)(ws + WS_WO + l * WO_BYTES), M_TOK, DM, DM}; pg8::StaticOrder S; S.init(M_TOK, DM, G, bx);
          pg8::EpiMix E; E.SA = SA; E.SB = SB; E.MIX = MIX;
          pg8::gemm_phase<pg8::EpiMix, pg8::StaticOrder, true, true>(lds + RING_OFF, g, S, E); }
        GRID_BAR();
        { pg8::Gemm g{MIX, (const bf16*)(ws + WS_WOUT + l * WOUT_BYTES), M_TOK, DM, DM}; pg8::StaticOrder S; S.init(M_TOK, DM, G, bx);
          pg8::EpiRes E; E.xin = xin; E.xout = out; E.gate = modl + 2048;
          pg8::gemm_phase<pg8::EpiRes, pg8::StaticOrder, true, true>(lds + RING_OFF, g, S, E); }
        GRID_BAR();
        { FRESH_IDS();
        for (int m = gw; m < M_TOK; m += NGW) { const int b = m >> 11; norm_row(out + (size_t)m * DM, rms_mlp + l * DM, modl + (size_t)b * 6144 + 3072, modl + (size_t)b * 6144 + 4096, XN + (size_t)m * DM, lane); } }
        GRID_BAR();
        { pg8::Gemm g{XN, (const bf16*)(ws + WS_WUP + l * WUP_BYTES), M_TOK, FFD, DM}; pg8::StaticOrder S; S.init(M_TOK, FFD, G, bx);
          pg8::EpiUp E; E.H = H;
          pg8::gemm_phase<pg8::EpiUp, pg8::StaticOrder, true, true>(lds + RING_OFF, g, S, E); }
        GRID_BAR();
        { pg8::Gemm g{H, (const bf16*)(ws + WS_WDN + l * WDN_BYTES), M_TOK, DM, FFD}; pg8::StaticOrder S; S.init(M_TOK, DM, G, bx);
          pg8::EpiRes E; E.xin = out; E.xout = out; E.gate = modl + 5120;
          pg8::gemm_phase<pg8::EpiRes, pg8::StaticOrder, true, true>(lds + RING_OFF, g, S, E); }
        if (l + 1 < NLAYER) GRID_BAR();
    }
#undef GRID_BAR
}

extern "C" void kernel_launch(void* const* d_in, const int* in_sizes, int n_in, void* d_out, int out_size, void* d_ws, size_t ws_size, hipStream_t stream) {
    static int grid = 0;
    if (grid == 0) {
        if (n_in != 18 || in_sizes[0] != M_TOK * DM || out_size != M_TOK * DM || ws_size < WS_END) { fprintf(stderr, "kernel_launch: unexpected shapes (n_in %d, ws %zu)\n", n_in, ws_size); grid = -1; return; }
        int dev = 0, cus = 0, per_cu = 0;
        if (hipGetDevice(&dev) != hipSuccess || hipDeviceGetAttribute(&cus, hipDeviceAttributeMultiprocessorCount, dev) != hipSuccess) { grid = -1; return; }
        if (hipFuncSetAttribute((const void*)mega_fwd, hipFuncAttributeMaxDynamicSharedMemorySize, LDS_BYTES) != hipSuccess) { fprintf(stderr, "kernel_launch: hipFuncSetAttribute failed\n"); grid = -1; return; }
        if (hipOccupancyMaxActiveBlocksPerMultiprocessor(&per_cu, (const void*)mega_fwd, NWAVES * 64, LDS_BYTES) != hipSuccess || per_cu < 1)
            fprintf(stderr, "kernel_launch: note: occupancy query reports %d workgroups per CU\n", per_cu);
        (void)hipGetLastError();
        grid = cus;
    }
    if (grid < 0) return;
    (void)hipMemsetAsync((char*)d_ws + WS_CTL, 0, CTL_BYTES, stream);
    MArgs a{};
    for (int i = 0; i < 18; ++i) a.in[i] = d_in[i];
    a.out = (float*)d_out; a.ws = (unsigned char*)d_ws;
    hipLaunchKernelGGL(mega_fwd, dim3(grid), dim3(NWAVES * 64), LDS_BYTES, stream, a);
}
```
